# Optimizing an MI355X kernel written in HIP

```python
import math
import jax, jax.numpy as jnp
from jax import lax
import numpy as np

D_MODEL = 1024
BATCH = 8
SEQ = 4096
DEPTH = 4

GRID_W = 64
WIN_ROWS = 8
WIN_COLS = 16
NA_HEADS = 16
NA_HEAD_DIM = D_MODEL // NA_HEADS
DIFF_HEADS = 8
DIFF_HEAD_DIM = D_MODEL // (2 * DIFF_HEADS)
Q_BLOCK = 128
N_BUCKETS = 32
MAX_DISTANCE = 128
N_GROUPS = 4
EXPERTS_PER_GROUP = 4
N_EXPERTS = N_GROUPS * EXPERTS_PER_GROUP
TOP_K_INNER = 2
D_EXPERT = 512
MOE_BLOCK = 256
N_MIXERS = 2
N_NA_LAYERS = (DEPTH + 1) // 2
N_DIFF_LAYERS = DEPTH // 2
RMS_EPS = 1e-6

kernel_name = 'hybrid_natten_diffattn_hmoe_encoder'


def _rms_norm(x, g):
    xf = x.astype(jnp.float32)
    y = xf * lax.rsqrt(jnp.mean(xf * xf, axis=-1, keepdims=True) + RMS_EPS)
    return (y * g.astype(jnp.float32)).astype(x.dtype)


def _t5_bucket(rel):
    half = N_BUCKETS // 2
    max_exact = half // 2
    ret = jnp.where(rel > 0, half, 0)
    n = jnp.abs(rel)
    nf = jnp.maximum(n, 1).astype(jnp.float32)
    large = max_exact + (jnp.log(nf / max_exact) / math.log(MAX_DISTANCE / max_exact)
                         * (half - max_exact)).astype(jnp.int32)
    large = jnp.minimum(large, half - 1)
    return ret + jnp.where(n < max_exact, n, large)


def neighborhood_attention(h, w_qkv, w_o, q_g, k_g, rpb):
    b, t, d = h.shape
    rows = t // GRID_W
    kh = min(WIN_ROWS, rows)
    qkv = (h @ w_qkv).reshape(b, rows, GRID_W, 3, NA_HEADS, NA_HEAD_DIM)
    q = _rms_norm(qkv[:, :, :, 0], q_g)
    k = _rms_norm(qkv[:, :, :, 1], k_g)
    v = qkv[:, :, :, 2]
    row_start = jnp.clip(jnp.arange(rows) - kh // 2, 0, rows - kh)
    col_start = jnp.clip(jnp.arange(GRID_W) - WIN_COLS // 2, 0, GRID_W - WIN_COLS)
    col_idx = col_start[:, None] + jnp.arange(WIN_COLS)[None, :]
    col_off = col_idx - jnp.arange(GRID_W)[:, None] + (WIN_COLS - 1)
    scale = NA_HEAD_DIM ** -0.5

    def one_row(r):
        rs = row_start[r]
        q_r = lax.dynamic_index_in_dim(q, r, axis=1, keepdims=False)
        k_win = lax.dynamic_slice_in_dim(k, rs, kh, axis=1)[:, :, col_idx]
        v_win = lax.dynamic_slice_in_dim(v, rs, kh, axis=1)[:, :, col_idx]
        row_off = rs + jnp.arange(kh) - r + (WIN_ROWS - 1)
        bias = rpb[:, row_off[None, :, None], col_off[:, None, :]]
        s = (jnp.einsum('bqhd,bkqwhd->bhqkw', q_r, k_win).astype(jnp.float32) * scale
             + bias.astype(jnp.float32)[None])
        p = jax.nn.softmax(s.reshape(b, NA_HEADS, GRID_W, kh * WIN_COLS), axis=-1)
        p = p.reshape(s.shape).astype(v.dtype)
        return jnp.einsum('bhqkw,bkqwhd->bqhd', p, v_win)

    o = lax.map(one_row, jnp.arange(rows))
    o = o.transpose(1, 0, 2, 3, 4).reshape(b, t, d)
    return o @ w_o


def differential_attention(h, w_qkv, w_o, q_g, k_g, lq1, lk1, lq2, lk2, subln_g, rel_bias, lambda_init):
    b, t, d = h.shape
    qkv = h @ w_qkv
    q = _rms_norm(qkv[..., :d].reshape(b, t, DIFF_HEADS, 2, DIFF_HEAD_DIM), q_g).transpose(0, 2, 3, 1, 4)
    k = _rms_norm(qkv[..., d:2 * d].reshape(b, t, DIFF_HEADS, 2, DIFF_HEAD_DIM), k_g).transpose(0, 2, 3, 1, 4)
    v = qkv[..., 2 * d:].reshape(b, t, DIFF_HEADS, 2 * DIFF_HEAD_DIM).transpose(0, 2, 1, 3)
    f32 = jnp.float32
    lam = (jnp.exp(jnp.sum(lq1.astype(f32) * lk1.astype(f32)))
           - jnp.exp(jnp.sum(lq2.astype(f32) * lk2.astype(f32))) + lambda_init)
    k_pos = jnp.arange(t)
    scale = DIFF_HEAD_DIM ** -0.5

    def one_block(i):
        q0 = i * Q_BLOCK
        qb = lax.dynamic_slice_in_dim(q, q0, Q_BLOCK, axis=3)
        rel = k_pos[None, :] - (q0 + jnp.arange(Q_BLOCK))[:, None]
        bias = rel_bias[_t5_bucket(rel)].astype(f32).transpose(2, 0, 1)
        s = jnp.einsum('bhcqd,bhckd->bhcqk', qb, k).astype(f32) * scale + bias[None, :, None]
        p = jax.nn.softmax(s, axis=-1)
        a = (p[:, :, 0] - lam * p[:, :, 1]).astype(v.dtype)
        return jnp.einsum('bhqk,bhkd->bqhd', a, v)

    o = lax.map(one_block, jnp.arange(t // Q_BLOCK))
    o = o.transpose(1, 0, 2, 3, 4).reshape(b, t, DIFF_HEADS, 2 * DIFF_HEAD_DIM)
    o = _rms_norm(o, subln_g) * (1.0 - lambda_init)
    return o.reshape(b, t, d) @ w_o


def hierarchical_moe(h, wr_g, br_g, wr_e, br_e, w_gate, w_up, w_down):
    b, t, d = h.shape
    n_tok = b * t
    xt = h.reshape(n_tok, d)
    f32 = jnp.float32
    g_prob = jax.nn.softmax((xt @ wr_g + br_g).astype(f32), axis=-1)
    g_p, g_idx = lax.top_k(g_prob, 1)
    e_logits = (xt @ wr_e + br_e).astype(f32).reshape(n_tok, N_GROUPS, EXPERTS_PER_GROUP)
    e_in = jnp.take_along_axis(e_logits, g_idx[:, :, None], axis=1)[:, 0]
    e_l, e_idx = lax.top_k(e_in, TOP_K_INNER)
    gate = jax.nn.softmax(e_l, axis=-1) * g_p
    expert = g_idx * EXPERTS_PER_GROUP + e_idx
    n_assign = n_tok * TOP_K_INNER
    flat_e = expert.reshape(n_assign)
    flat_tok = jnp.repeat(jnp.arange(n_tok, dtype=jnp.int32), TOP_K_INNER)
    flat_w = gate.reshape(n_assign)
    order = jnp.argsort(flat_e)
    sorted_e = flat_e[order]
    counts = jnp.bincount(flat_e, length=N_EXPERTS)
    starts = jnp.cumsum(counts) - counts
    padded = (counts + MOE_BLOCK - 1) // MOE_BLOCK * MOE_BLOCK
    padded_end = jnp.cumsum(padded)
    padded_start = padded_end - padded
    dest = padded_start[sorted_e] + jnp.arange(n_assign) - starts[sorted_e]
    n_blocks = -(-n_assign // MOE_BLOCK) + N_EXPERTS
    cap = n_blocks * MOE_BLOCK
    slot_tok = jnp.zeros((cap,), jnp.int32).at[dest].set(flat_tok[order])
    slot_w = jnp.zeros((cap,), f32).at[dest].set(flat_w[order])
    block_expert = jnp.minimum(
        jnp.searchsorted(padded_end, jnp.arange(n_blocks) * MOE_BLOCK, side='right'), N_EXPERTS - 1)
    xs = xt[slot_tok].reshape(n_blocks, MOE_BLOCK, d)

    def expert_block(args):
        xb, e = args
        hid = jax.nn.silu(xb @ w_gate[e]) * (xb @ w_up[e])
        return hid @ w_down[e]

    ys = lax.map(expert_block, (xs, block_expert)).reshape(cap, d)
    y = jnp.zeros_like(xt).at[slot_tok].add(ys * slot_w[:, None].astype(ys.dtype))
    return y.reshape(b, t, d)


def setup_inputs(seed: int = 0) -> dict:
    key = jax.random.key(seed)
    ks = jax.random.split(key, 26)
    f32 = jnp.float32
    D = D_MODEL

    def nrm(k, shape, scale):
        return jax.random.normal(k, shape, f32) * scale

    return {
        'x': nrm(ks[0], (BATCH, SEQ, D), 1.0),
        'mix_norm_g': 1.0 + nrm(ks[1], (DEPTH, D), 0.02),
        'ffn_norm_g': 1.0 + nrm(ks[2], (DEPTH, D), 0.02),
        'na_w_qkv': nrm(ks[3], (N_NA_LAYERS, D, 3 * D), D ** -0.5),
        'na_w_o': nrm(ks[4], (N_NA_LAYERS, D, D), D ** -0.5),
        'na_q_g': 1.0 + nrm(ks[5], (N_NA_LAYERS, NA_HEAD_DIM), 0.02),
        'na_k_g': 1.0 + nrm(ks[6], (N_NA_LAYERS, NA_HEAD_DIM), 0.02),
        'na_rpb': nrm(ks[7], (N_NA_LAYERS, NA_HEADS, 2 * WIN_ROWS - 1, 2 * WIN_COLS - 1), 0.1),
        'diff_w_qkv': nrm(ks[8], (N_DIFF_LAYERS, D, 3 * D), D ** -0.5),
        'diff_w_o': nrm(ks[9], (N_DIFF_LAYERS, D, D), D ** -0.5),
        'diff_q_g': 1.0 + nrm(ks[10], (N_DIFF_LAYERS, DIFF_HEAD_DIM), 0.02),
        'diff_k_g': 1.0 + nrm(ks[11], (N_DIFF_LAYERS, DIFF_HEAD_DIM), 0.02),
        'diff_lq1': nrm(ks[12], (N_DIFF_LAYERS, DIFF_HEAD_DIM), 0.1),
        'diff_lk1': nrm(ks[13], (N_DIFF_LAYERS, DIFF_HEAD_DIM), 0.1),
        'diff_lq2': nrm(ks[14], (N_DIFF_LAYERS, DIFF_HEAD_DIM), 0.1),
        'diff_lk2': nrm(ks[15], (N_DIFF_LAYERS, DIFF_HEAD_DIM), 0.1),
        'diff_subln_g': 1.0 + nrm(ks[16], (N_DIFF_LAYERS, 2 * DIFF_HEAD_DIM), 0.02),
        'rel_bias': nrm(ks[17], (N_BUCKETS, DIFF_HEADS), 0.1),
        'router_group_w': nrm(ks[18], (DEPTH, D, N_GROUPS), D ** -0.5),
        'router_group_b': nrm(ks[19], (DEPTH, N_GROUPS), 0.01),
        'router_expert_w': nrm(ks[20], (DEPTH, D, N_EXPERTS), D ** -0.5),
        'router_expert_b': nrm(ks[21], (DEPTH, N_EXPERTS), 0.01),
        'moe_w_gate': nrm(ks[22], (DEPTH, N_EXPERTS, D, D_EXPERT), D ** -0.5),
        'moe_w_up': nrm(ks[23], (DEPTH, N_EXPERTS, D, D_EXPERT), D ** -0.5),
        'moe_w_down': nrm(ks[24], (DEPTH, N_EXPERTS, D_EXPERT, D), D_EXPERT ** -0.5),
    }


def reference(x, mix_norm_g, ffn_norm_g, na_w_qkv, na_w_o, na_q_g, na_k_g, na_rpb,
              diff_w_qkv, diff_w_o, diff_q_g, diff_k_g, diff_lq1, diff_lk1, diff_lq2, diff_lk2,
              diff_subln_g, rel_bias, router_group_w, router_group_b, router_expert_w,
              router_expert_b, moe_w_gate, moe_w_up, moe_w_down):
    for i in range(DEPTH):
        j = i // N_MIXERS
        h = _rms_norm(x, mix_norm_g[i])
        if i % N_MIXERS == 0:
            x = x + neighborhood_attention(h, na_w_qkv[j], na_w_o[j], na_q_g[j], na_k_g[j], na_rpb[j])
        else:
            lambda_init = 0.8 - 0.6 * math.exp(-0.3 * i)
            x = x + differential_attention(h, diff_w_qkv[j], diff_w_o[j], diff_q_g[j], diff_k_g[j],
                                           diff_lq1[j], diff_lk1[j], diff_lq2[j], diff_lk2[j],
                                           diff_subln_g[j], rel_bias, lambda_init)
        h = _rms_norm(x, ffn_norm_g[i])
        x = x + hierarchical_moe(h, router_group_w[i], router_group_b[i], router_expert_w[i],
                                 router_expert_b[i], moe_w_gate[i], moe_w_up[i], moe_w_down[i])
    return x
```

```cpp
#include <hip/hip_runtime.h>
#include <stdint.h>
#include <cstdio>

typedef unsigned short bf16_t;
typedef short bf16x8 __attribute__((ext_vector_type(8)));
typedef float f32x4 __attribute__((ext_vector_type(4)));
typedef unsigned u32x4 __attribute__((ext_vector_type(4)));
typedef unsigned u32x2 __attribute__((ext_vector_type(2)));

constexpr int BATCH = 8, SEQ = 4096, D = 1024, M = BATCH * SEQ, DEPTH = 4;
constexpr int NE = 16, DE = 512, NGRP = 4;
constexpr int CAP = (2 * M / 256 + NE) * 256;
constexpr int MAXT = CAP / 256;
constexpr float RMS_EPS = 1e-6f;

constexpr size_t MiB = 1u << 20;
constexpr size_t WS_CTL = 0;
constexpr size_t WS_WQKV = 1 * MiB;
constexpr size_t WS_WO = 7 * MiB;
constexpr size_t WS_WGU = 9 * MiB;
constexpr size_t WS_WD = 41 * MiB;
constexpr size_t WS_XN = 57 * MiB;
constexpr size_t WS_QKV = 121 * MiB;
constexpr size_t WS_AO = 313 * MiB;
constexpr size_t WS_H = WS_QKV;
constexpr size_t WS_Y = WS_QKV + 68 * MiB;
constexpr size_t WS_TOK = 377 * MiB;
constexpr size_t WS_TBL = 380 * MiB;
constexpr size_t WS_END = 384 * MiB;
constexpr int CW_CNT = 1024;
constexpr int CW_CUR = 2048;

struct TokArrays { int* tok_e; float* tok_w; int* tok_slot; int* slot_tok; };

__device__ __forceinline__ unsigned f2bf(float f) { unsigned u = __builtin_bit_cast(unsigned, f); return (u + 0x7fffu + ((u >> 16) & 1u)) >> 16; }
__device__ __forceinline__ float bf2f(unsigned short b) { return __builtin_bit_cast(float, (unsigned)b << 16); }
__device__ __forceinline__ unsigned pk2(float lo, float hi) { return f2bf(lo) | (f2bf(hi) << 16); }
__device__ __forceinline__ float wave_sum(float v) {
#pragma unroll
    for (int o = 1; o < 64; o <<= 1) v += __shfl_xor(v, o);
    return v;
}

__global__ void __launch_bounds__(256) k_transpose(const float* __restrict__ W, bf16_t* __restrict__ Wt, int K, int N, int grp, int gstride, int goff, int pad_,
                                                   size_t src_bstride, size_t dst_bstride) {
    __shared__ float tile[32][33];
    W += (size_t)blockIdx.z * src_bstride; Wt += (size_t)blockIdx.z * dst_bstride;
    const int n0 = blockIdx.x * 32, k0 = blockIdx.y * 32, tx = threadIdx.x & 31, ty = threadIdx.x >> 5;
#pragma unroll
    for (int i = 0; i < 4; ++i) tile[ty + 8 * i][tx] = W[(size_t)(k0 + ty + 8 * i) * N + n0 + tx];
    __syncthreads();
#pragma unroll
    for (int i = 0; i < 4; ++i) { const int n = n0 + ty + 8 * i; const int dr = (n / grp) * gstride + goff + n % grp;
        Wt[(size_t)dr * K + k0 + tx] = (bf16_t)f2bf(tile[tx][ty + 8 * i]); }
}

__global__ void __launch_bounds__(256) k_rmsnorm(const float* __restrict__ x, const float* __restrict__ g, bf16_t* __restrict__ out) {
    const int lane = threadIdx.x & 63, row = blockIdx.x * 4 + (threadIdx.x >> 6);
    const f32x4* xr = (const f32x4*)(x + (size_t)row * D) + lane;
    f32x4 v[4]; float s = 0.f;
#pragma unroll
    for (int j = 0; j < 4; ++j) { v[j] = xr[64 * j]; s += v[j].x * v[j].x + v[j].y * v[j].y + v[j].z * v[j].z + v[j].w * v[j].w; }
    const float r = rsqrtf(wave_sum(s) * (1.f / D) + RMS_EPS);
    u32x2* o = (u32x2*)(out + (size_t)row * D) + lane;
#pragma unroll
    for (int j = 0; j < 4; ++j) { const f32x4 gg = ((const f32x4*)g)[lane + 64 * j]; u32x2 w; w.x = pk2(v[j].x * r * gg.x, v[j].y * r * gg.y); w.y = pk2(v[j].z * r * gg.z, v[j].w * r * gg.w); o[64 * j] = w; }
}

template <class Epi>
__global__ void __launch_bounds__(256) k_gemm(const bf16_t* __restrict__ A, const bf16_t* __restrict__ Bt, int K, int lda, int ldb, int pad_, Epi E) {
    const int lane = threadIdx.x & 63, wid = threadIdx.x >> 6, wr = wid >> 1, wc = wid & 1, fr = lane & 15, fq = lane >> 4;
    const int row0 = blockIdx.y * 128 + wr * 64, col0 = blockIdx.x * 128 + wc * 64;
    f32x4 acc[4][4];
#pragma unroll
    for (int m = 0; m < 4; ++m)
#pragma unroll
        for (int n = 0; n < 4; ++n) acc[m][n] = (f32x4){0.f, 0.f, 0.f, 0.f};
    const bf16_t* ap = A + (size_t)(row0 + fr) * lda + fq * 8;
    const bf16_t* bp = Bt + (size_t)(col0 + fr) * ldb + fq * 8;
    for (int k = 0; k < K; k += 32) {
        bf16x8 a[4], b[4];
#pragma unroll
        for (int m = 0; m < 4; ++m) a[m] = *(const bf16x8*)(ap + (size_t)m * 16 * lda + k);
#pragma unroll
        for (int n = 0; n < 4; ++n) b[n] = *(const bf16x8*)(bp + (size_t)n * 16 * ldb + k);
#pragma unroll
        for (int m = 0; m < 4; ++m)
#pragma unroll
            for (int n = 0; n < 4; ++n) acc[m][n] = __builtin_amdgcn_mfma_f32_16x16x32_bf16(b[n], a[m], acc[m][n], 0, 0, 0);
    }
#pragma unroll
    for (int m = 0; m < 4; ++m)
#pragma unroll
        for (int n = 0; n < 4; ++n) E(row0 + m * 16 + fr, col0 + n * 16 + fq * 4, acc[m][n]);
}
struct EpiStoreBf16 { bf16_t* C; int ldc; int pad_;
    __device__ __forceinline__ void operator()(int r, int c, f32x4 v) const { u32x2 w; w.x = pk2(v.x, v.y); w.y = pk2(v.z, v.w); *(u32x2*)(C + (size_t)r * ldc + c) = w; } };
struct EpiResidual { const float* base; float* out; int ldc; int pad_;
    __device__ __forceinline__ void operator()(int r, int c, f32x4 v) const { const f32x4 b = *(const f32x4*)(base + (size_t)r * ldc + c); *(f32x4*)(out + (size_t)r * ldc + c) = b + v; } };

__global__ void __launch_bounds__(256) k_qknorm(bf16_t* __restrict__ qkv, const float* __restrict__ qg, const float* __restrict__ kg) {
    const int lane = threadIdx.x & 63, tok = blockIdx.x * 4 + (threadIdx.x >> 6);
    bf16_t* p = qkv + (size_t)tok * 3072;
#pragma unroll
    for (int pass = 0; pass < 4; ++pass) {
        const int e0 = pass * 512 + lane * 8;
        u32x4 raw = *(const u32x4*)(p + e0);
        float v[8];
#pragma unroll
        for (int i = 0; i < 4; ++i) { v[2 * i] = bf2f((unsigned short)(raw[i] & 0xffff)); v[2 * i + 1] = bf2f((unsigned short)(raw[i] >> 16)); }
        float s = 0.f;
#pragma unroll
        for (int i = 0; i < 8; ++i) s += v[i] * v[i];
        s += __shfl_xor(s, 1); s += __shfl_xor(s, 2); s += __shfl_xor(s, 4);
        const float r = rsqrtf(s * (1.f / 64.f) + RMS_EPS);
        const float* g = (e0 < 1024 ? qg : kg) + (e0 & 63);
        u32x4 w;
#pragma unroll
        for (int i = 0; i < 4; ++i) w[i] = pk2(v[2 * i] * r * g[2 * i], v[2 * i + 1] * r * g[2 * i + 1]);
        *(u32x4*)(p + e0) = w;
    }
}

__global__ void __launch_bounds__(256) k_na_attn(const bf16_t* __restrict__ qkv, const float* __restrict__ rpb, bf16_t* __restrict__ ao) {
    const int lane = threadIdx.x & 63, tok = blockIdx.x * 4 + (threadIdx.x >> 6);
    const int b = tok >> 12, t = tok & 4095, r = t >> 6, c = t & 63, h = lane >> 2, sub = lane & 3;
    int rs = r - 4; rs = rs < 0 ? 0 : (rs > 56 ? 56 : rs);
    int cs = c - 8; cs = cs < 0 ? 0 : (cs > 48 ? 48 : cs);
    float q[16], o[16];
    { const bf16_t* qp = qkv + (size_t)tok * 3072 + h * 64 + sub * 16;
#pragma unroll
      for (int i = 0; i < 16; ++i) { q[i] = bf2f(qp[i]); o[i] = 0.f; } }
    float mx = -1e30f, l = 0.f;
    for (int i = 0; i < 8; ++i) for (int j = 0; j < 16; ++j) {
        const int kr = rs + i, kc = cs + j; const size_t kt = (size_t)(b * 4096 + kr * 64 + kc) * 3072;
        const bf16_t* kp = qkv + kt + 1024 + h * 64 + sub * 16; const bf16_t* vp = qkv + kt + 2048 + h * 64 + sub * 16;
        float d = 0.f;
#pragma unroll
        for (int e = 0; e < 16; ++e) d += q[e] * bf2f(kp[e]);
        d += __shfl_xor(d, 1); d += __shfl_xor(d, 2);
        const float s = d * 0.125f + rpb[(h * 15 + (kr - r + 7)) * 31 + (kc - c + 15)];
        const float mn = fmaxf(mx, s), sc = __expf(mx - mn), p = __expf(s - mn);
        l = l * sc + p; mx = mn;
#pragma unroll
        for (int e = 0; e < 16; ++e) o[e] = o[e] * sc + p * bf2f(vp[e]);
    }
    const float il = 1.f / l;
    bf16_t* op = ao + (size_t)tok * 1024 + h * 64 + sub * 16;
#pragma unroll
    for (int e = 0; e < 16; ++e) op[e] = (bf16_t)f2bf(o[e] * il);
}

__global__ void k_t5table(const float* __restrict__ rel_bias, float* __restrict__ tbl, const float* lq1, const float* lk1, const float* lq2, const float* lk2, float* lamp, float lambda_init, float pad_) {
    const int i = blockIdx.x * blockDim.x + threadIdx.x;
    if (i < 8191 * 8) {
        const int rel = i / 8 - 4095, h = i % 8, n = rel < 0 ? -rel : rel;
        int bk;
        if (n < 8) bk = n; else { bk = 8 + (n >= 12) + (n >= 16) + (n >= 23) + (n >= 32) + (n >= 46) + (n >= 64) + (n >= 91); }
        bk += rel > 0 ? 16 : 0;
        tbl[i] = rel_bias[bk * 8 + h];
    }
    if (i == 0) { float s1 = 0.f, s2 = 0.f; for (int e = 0; e < 64; ++e) { s1 += lq1[e] * lk1[e]; s2 += lq2[e] * lk2[e]; } lamp[0] = expf(s1) - expf(s2) + lambda_init; }
}

__global__ void __launch_bounds__(512) k_diff_attn(const bf16_t* __restrict__ qkv, const float* __restrict__ tbl, const float* __restrict__ lamp, const float* __restrict__ subg, bf16_t* __restrict__ ao, float one_minus_li, float pad_) {
    __shared__ __attribute__((aligned(16))) bf16_t kv[16][2048];
    const int lane = threadIdx.x & 63, w = threadIdx.x >> 6, tok = blockIdx.x * 8 + w;
    const int b = tok >> 12, tq = tok & 4095, h = lane >> 3, c = (lane >> 2) & 1, sub = lane & 3;
    float q[16], o[32];
    { const bf16_t* qp = qkv + (size_t)tok * 3072 + h * 128 + c * 64 + sub * 16;
#pragma unroll
      for (int i = 0; i < 16; ++i) q[i] = bf2f(qp[i]);
#pragma unroll
      for (int i = 0; i < 32; ++i) o[i] = 0.f; }
    float mx = -1e30f, l = 0.f;
    for (int k0 = 0; k0 < SEQ; k0 += 16) {
        __syncthreads();
#pragma unroll
        for (int i = 0; i < 8; ++i) { const int idx = threadIdx.x + 512 * i, key = idx >> 8, ch = idx & 255;
            *(u32x4*)(&kv[key][ch * 8]) = *(const u32x4*)(qkv + (size_t)(b * 4096 + k0 + key) * 3072 + 1024 + ch * 8); }
        __syncthreads();
        for (int kk = 0; kk < 16; ++kk) {
            const bf16_t* kp = &kv[kk][h * 128 + c * 64 + sub * 16];
            float d = 0.f;
#pragma unroll
            for (int e = 0; e < 16; ++e) d += q[e] * bf2f(kp[e]);
            d += __shfl_xor(d, 1); d += __shfl_xor(d, 2);
            const float s = d * 0.125f + tbl[(k0 + kk - tq + 4095) * 8 + h];
            const float mn = fmaxf(mx, s), sc = __expf(mx - mn), p = __expf(s - mn);
            l = l * sc + p; mx = mn;
            const bf16_t* vp = &kv[kk][1024 + h * 128 + sub * 32];
#pragma unroll
            for (int e = 0; e < 32; ++e) o[e] = o[e] * sc + p * bf2f(vp[e]);
        }
    }
    const float il = 1.f / l, lam = lamp[0];
    float ss = 0.f; float r[32];
#pragma unroll
    for (int e = 0; e < 32; ++e) { const float mine = o[e] * il; const float other = __shfl_xor(mine, 4); r[e] = mine - lam * other; ss += r[e] * r[e]; }
    ss += __shfl_xor(ss, 1); ss += __shfl_xor(ss, 2);
    const float rn = rsqrtf(ss * (1.f / 128.f) + RMS_EPS) * one_minus_li;
    if (c == 0) { bf16_t* op = ao + (size_t)tok * 1024 + h * 128 + sub * 32;
#pragma unroll
        for (int e = 0; e < 32; ++e) op[e] = (bf16_t)f2bf(r[e] * rn * subg[sub * 32 + e]); }
}

__global__ void __launch_bounds__(256) k_norm_router(const float* __restrict__ x, const float* __restrict__ g, const float* __restrict__ wg, const float* __restrict__ bg,
                                                     const float* __restrict__ we, const float* __restrict__ be, bf16_t* __restrict__ xn, TokArrays T, unsigned* __restrict__ cnt) {
    const int lane = threadIdx.x & 63, tok = blockIdx.x * 4 + (threadIdx.x >> 6);
    const f32x4* xr = (const f32x4*)(x + (size_t)tok * D) + lane;
    f32x4 v[4]; float s = 0.f;
#pragma unroll
    for (int j = 0; j < 4; ++j) { v[j] = xr[64 * j]; s += v[j].x * v[j].x + v[j].y * v[j].y + v[j].z * v[j].z + v[j].w * v[j].w; }
    const float r = rsqrtf(wave_sum(s) * (1.f / D) + RMS_EPS);
    float lg[20];
#pragma unroll
    for (int i = 0; i < 20; ++i) lg[i] = 0.f;
    u32x2* o = (u32x2*)(xn + (size_t)tok * D) + lane;
#pragma unroll
    for (int j = 0; j < 4; ++j) { const f32x4 gg = ((const f32x4*)g)[lane + 64 * j];
        float hv[4] = {v[j].x * r * gg.x, v[j].y * r * gg.y, v[j].z * r * gg.z, v[j].w * r * gg.w};
        u32x2 w; w.x = pk2(hv[0], hv[1]); w.y = pk2(hv[2], hv[3]); o[64 * j] = w;
#pragma unroll
        for (int e = 0; e < 4; ++e) { const int col = (lane + 64 * j) * 4 + e;
            const f32x4 wgv = *(const f32x4*)(wg + (size_t)col * 4);
            lg[0] += hv[e] * wgv.x; lg[1] += hv[e] * wgv.y; lg[2] += hv[e] * wgv.z; lg[3] += hv[e] * wgv.w;
#pragma unroll
            for (int q4 = 0; q4 < 4; ++q4) { const f32x4 wev = *(const f32x4*)(we + (size_t)col * 16 + q4 * 4);
                lg[4 + q4 * 4 + 0] += hv[e] * wev.x; lg[4 + q4 * 4 + 1] += hv[e] * wev.y; lg[4 + q4 * 4 + 2] += hv[e] * wev.z; lg[4 + q4 * 4 + 3] += hv[e] * wev.w; } } }
#pragma unroll
    for (int i = 0; i < 20; ++i) lg[i] = wave_sum(lg[i]);
    if (lane == 0) {
        float gl[4]; int gi = 0; float gm = -1e30f;
#pragma unroll
        for (int i = 0; i < 4; ++i) { gl[i] = lg[i] + bg[i]; if (gl[i] > gm) { gm = gl[i]; gi = i; } }
        float gs = 0.f;
#pragma unroll
        for (int i = 0; i < 4; ++i) gs += __expf(gl[i] - gm);
        const float gp = 1.f / gs;
        float el[4];
#pragma unroll
        for (int i = 0; i < 4; ++i) { float t = 0.f;
#pragma unroll
            for (int gq = 0; gq < 4; ++gq) t = (gq == gi) ? (lg[4 + gq * 4 + i] + be[gq * 4 + i]) : t;
            el[i] = t; }
        int i0 = 0; float m0 = el[0];
#pragma unroll
        for (int i = 1; i < 4; ++i) if (el[i] > m0) { m0 = el[i]; i0 = i; }
        int i1 = -1; float m1 = -1e30f;
#pragma unroll
        for (int i = 0; i < 4; ++i) if (i != i0 && el[i] > m1) { m1 = el[i]; i1 = i; }
        const float e1 = __expf(m1 - m0), w0 = gp / (1.f + e1), w1 = gp * e1 / (1.f + e1);
        const int E0 = gi * 4 + i0, E1 = gi * 4 + i1;
        T.tok_e[tok * 2] = E0; T.tok_e[tok * 2 + 1] = E1; T.tok_w[tok * 2] = w0; T.tok_w[tok * 2 + 1] = w1;
        atomicAdd(&cnt[E0], 1u); atomicAdd(&cnt[E1], 1u);
    }
}

struct MoeMap { int pstart[NE]; int ntiles; };
__device__ __forceinline__ void moe_offsets(const unsigned* cnt, int* pstart, int* pcount) {
    int acc = 0;
#pragma unroll
    for (int e = 0; e < NE; ++e) { const int c = (int)cnt[e]; pstart[e] = acc; pcount[e] = c; acc += (c + 255) / 256 * 256; }
}
__global__ void __launch_bounds__(256) k_assign(const unsigned* __restrict__ cnt, unsigned* __restrict__ cur, TokArrays T, int* __restrict__ tile_e) {
    int pstart[NE], pcount[NE]; moe_offsets(cnt, pstart, pcount);
    const int tok = blockIdx.x * 256 + threadIdx.x;
#pragma unroll
    for (int k = 0; k < 2; ++k) { const int e = T.tok_e[tok * 2 + k]; int ps = 0;
#pragma unroll
        for (int i = 0; i < NE; ++i) ps = (i == e) ? pstart[i] : ps;
        const int slot = ps + (int)atomicAdd(&cur[e], 1u); T.slot_tok[slot] = tok; T.tok_slot[tok * 2 + k] = slot; }
    if (blockIdx.x == 0) {
        for (int i = threadIdx.x; i < NE * 256; i += 256) { const int e = i >> 8, j = i & 255; int ps = 0, pc = 0;
#pragma unroll
            for (int q = 0; q < NE; ++q) { ps = (q == e) ? pstart[q] : ps; pc = (q == e) ? pcount[q] : pc; }
            const int padded = (pc + 255) / 256 * 256; if (pc + j < padded) T.slot_tok[ps + pc + j] = 0; }
        for (int tI = threadIdx.x; tI < MAXT + 1; tI += 256) { int e = -1;
#pragma unroll
            for (int q = 0; q < NE; ++q) { const int padded = (pcount[q] + 255) / 256 * 256; if (tI * 256 >= pstart[q] && tI * 256 < pstart[q] + padded) e = q; }
            tile_e[tI] = e; }
    }
}

__global__ void __launch_bounds__(256) k_moe_gateup(const bf16_t* __restrict__ xn, const bf16_t* __restrict__ wgu, const int* __restrict__ slot_tok, const int* __restrict__ tile_e, bf16_t* __restrict__ H) {
    const int lane = threadIdx.x & 63, wid = threadIdx.x >> 6, wr = wid >> 1, wc = wid & 1, fr = lane & 15, fq = lane >> 4;
    const int row0 = blockIdx.y * 128 + wr * 64; const int e = tile_e[row0 >> 8]; if (e < 0) return;
    const int hid0 = blockIdx.x * 64 + wc * 32;
    const int tile = hid0 >> 7, j0 = hid0 & 127;
    const bf16_t* B = wgu + (size_t)e * 1024 * 1024;
    f32x4 ag[4][2], au[4][2];
#pragma unroll
    for (int m = 0; m < 4; ++m)
#pragma unroll
        for (int n = 0; n < 2; ++n) { ag[m][n] = (f32x4){0.f, 0.f, 0.f, 0.f}; au[m][n] = (f32x4){0.f, 0.f, 0.f, 0.f}; }
    const bf16_t* ap[4];
#pragma unroll
    for (int m = 0; m < 4; ++m) ap[m] = xn + (size_t)slot_tok[row0 + m * 16 + fr] * 1024 + fq * 8;
    const bf16_t* bg = B + (size_t)(tile * 256 + j0 + fr) * 1024 + fq * 8;
    const bf16_t* bu = bg + (size_t)128 * 1024;
    for (int k = 0; k < 1024; k += 32) {
        bf16x8 a[4], g[2], u[2];
#pragma unroll
        for (int m = 0; m < 4; ++m) a[m] = *(const bf16x8*)(ap[m] + k);
#pragma unroll
        for (int n = 0; n < 2; ++n) { g[n] = *(const bf16x8*)(bg + (size_t)n * 16 * 1024 + k); u[n] = *(const bf16x8*)(bu + (size_t)n * 16 * 1024 + k); }
#pragma unroll
        for (int m = 0; m < 4; ++m)
#pragma unroll
            for (int n = 0; n < 2; ++n) { ag[m][n] = __builtin_amdgcn_mfma_f32_16x16x32_bf16(g[n], a[m], ag[m][n], 0, 0, 0); au[m][n] = __builtin_amdgcn_mfma_f32_16x16x32_bf16(u[n], a[m], au[m][n], 0, 0, 0); }
    }
#pragma unroll
    for (int m = 0; m < 4; ++m)
#pragma unroll
        for (int n = 0; n < 2; ++n) { float hv[4];
#pragma unroll
            for (int i = 0; i < 4; ++i) { const float gvv = ag[m][n][i]; hv[i] = gvv / (1.f + __expf(-gvv)) * au[m][n][i]; }
            u32x2 w; w.x = pk2(hv[0], hv[1]); w.y = pk2(hv[2], hv[3]);
            *(u32x2*)(H + (size_t)(row0 + m * 16 + fr) * 512 + hid0 + n * 16 + fq * 4) = w; }
}
__global__ void __launch_bounds__(256) k_moe_down(const bf16_t* __restrict__ H, const bf16_t* __restrict__ wd, const int* __restrict__ tile_e, bf16_t* __restrict__ Y) {
    const int lane = threadIdx.x & 63, wid = threadIdx.x >> 6, wr = wid >> 1, wc = wid & 1, fr = lane & 15, fq = lane >> 4;
    const int row0 = blockIdx.y * 128 + wr * 64, col0 = blockIdx.x * 128 + wc * 64; const int e = tile_e[row0 >> 8]; if (e < 0) return;
    const bf16_t* Bt = wd + (size_t)e * 1024 * 512;
    f32x4 acc[4][4];
#pragma unroll
    for (int m = 0; m < 4; ++m)
#pragma unroll
        for (int n = 0; n < 4; ++n) acc[m][n] = (f32x4){0.f, 0.f, 0.f, 0.f};
    const bf16_t* ap = H + (size_t)(row0 + fr) * 512 + fq * 8; const bf16_t* bp = Bt + (size_t)(col0 + fr) * 512 + fq * 8;
    for (int k = 0; k < 512; k += 32) {
        bf16x8 a[4], b[4];
#pragma unroll
        for (int m = 0; m < 4; ++m) a[m] = *(const bf16x8*)(ap + (size_t)m * 16 * 512 + k);
#pragma unroll
        for (int n = 0; n < 4; ++n) b[n] = *(const bf16x8*)(bp + (size_t)n * 16 * 512 + k);
#pragma unroll
        for (int m = 0; m < 4; ++m)
#pragma unroll
            for (int n = 0; n < 4; ++n) acc[m][n] = __builtin_amdgcn_mfma_f32_16x16x32_bf16(b[n], a[m], acc[m][n], 0, 0, 0);
    }
#pragma unroll
    for (int m = 0; m < 4; ++m)
#pragma unroll
        for (int n = 0; n < 4; ++n) { u32x2 w; w.x = pk2(acc[m][n].x, acc[m][n].y); w.y = pk2(acc[m][n].z, acc[m][n].w);
            *(u32x2*)(Y + (size_t)(row0 + m * 16 + fr) * 1024 + col0 + n * 16 + fq * 4) = w; }
}
__global__ void __launch_bounds__(256) k_combine(float* __restrict__ x, const bf16_t* __restrict__ Y, TokArrays T, const float* __restrict__ gnext, bf16_t* __restrict__ xn) {
    const int lane = threadIdx.x & 63, tok = blockIdx.x * 4 + (threadIdx.x >> 6);
    const int s0 = T.tok_slot[tok * 2], s1 = T.tok_slot[tok * 2 + 1]; const float w0 = T.tok_w[tok * 2], w1 = T.tok_w[tok * 2 + 1];
    f32x4* xr = (f32x4*)(x + (size_t)tok * D) + lane;
    const u32x2* y0 = (const u32x2*)(Y + (size_t)s0 * D) + lane; const u32x2* y1 = (const u32x2*)(Y + (size_t)s1 * D) + lane;
    f32x4 v[4]; float s = 0.f;
#pragma unroll
    for (int j = 0; j < 4; ++j) { v[j] = xr[64 * j]; const u32x2 a = y0[64 * j], b = y1[64 * j];
        v[j].x += w0 * bf2f(a.x & 0xffff) + w1 * bf2f(b.x & 0xffff); v[j].y += w0 * bf2f(a.x >> 16) + w1 * bf2f(b.x >> 16);
        v[j].z += w0 * bf2f(a.y & 0xffff) + w1 * bf2f(b.y & 0xffff); v[j].w += w0 * bf2f(a.y >> 16) + w1 * bf2f(b.y >> 16);
        xr[64 * j] = v[j]; s += v[j].x * v[j].x + v[j].y * v[j].y + v[j].z * v[j].z + v[j].w * v[j].w; }
    if (gnext) { const float r = rsqrtf(wave_sum(s) * (1.f / D) + RMS_EPS); u32x2* o = (u32x2*)(xn + (size_t)tok * D) + lane;
#pragma unroll
        for (int j = 0; j < 4; ++j) { const f32x4 gg = ((const f32x4*)gnext)[lane + 64 * j]; u32x2 w; w.x = pk2(v[j].x * r * gg.x, v[j].y * r * gg.y); w.y = pk2(v[j].z * r * gg.z, v[j].w * r * gg.w); o[64 * j] = w; } }
}

#define LAS __attribute__((address_space(3)))
#define GAS __attribute__((address_space(1)))
typedef GAS const float* gcf_t; typedef GAS float* gf_t; typedef GAS const bf16_t* gcb_t; typedef GAS bf16_t* gb_t; typedef GAS const int* gci_t; typedef GAS int* gi_t;
typedef GAS unsigned* gu_t; typedef GAS const unsigned* gcu_t; typedef GAS const char* gcc_t; typedef GAS unsigned char* guc_t;
struct TokG { gi_t tok_e; gf_t tok_w; gi_t tok_slot; gi_t slot_tok; };
#define DI __device__ __forceinline__
typedef short s16x4 __attribute__((ext_vector_type(4)));
typedef float f32x16 __attribute__((ext_vector_type(16)));
typedef float f32x2_t __attribute__((ext_vector_type(2)));
typedef __bf16 bf16x2_t __attribute__((ext_vector_type(2)));
constexpr float LOG2E = 1.4426950408889634f;
constexpr int NWAVES = 8, NTHREADS = 512;
constexpr size_t WS_WQKVP = 381 * MiB;
constexpr size_t WS_X16 = 388 * MiB;
constexpr size_t WS_END2 = 452 * MiB;
constexpr int CW_BAR = 16384;
constexpr int RING_BYTES = 131072;
constexpr int MISC_OFF = 147456;
constexpr int ROWS_OFF = MISC_OFF + 1024;
constexpr int LDS_BYTES = 155648;

DI unsigned cvtpk(float lo, float hi) { f32x2_t v = {lo, hi}; bf16x2_t b = __builtin_convertvector(v, bf16x2_t); return __builtin_bit_cast(unsigned, b); }
DI float uni(float v) { return __builtin_bit_cast(float, __builtin_amdgcn_readfirstlane(__builtin_bit_cast(int, v))); }
DI int fresh_lane() { int l; asm volatile("v_mbcnt_lo_u32_b32 %0, -1, 0\n\tv_mbcnt_hi_u32_b32 %0, -1, %0" : "=v"(l)); return l; }
#define SWZ_XOR(v, k) __builtin_bit_cast(float, __builtin_amdgcn_ds_swizzle(__builtin_bit_cast(int, (v)), ((k) << 10) | 0x1f))
DI float wave_max(float v) {
#pragma unroll
    for (int o = 1; o < 64; o <<= 1) v = fmaxf(v, __shfl_xor(v, o));
    return v;
}

#define XB_TMO      128
#define XB_XCNT(j)  (256  + 64 * (j))
#define XB_XSUB(j)  (1280 + 64 * (j))
#define XB_XGEN(j)  (2304 + 64 * (j))
#define XB_TOP      3328
#define XB_TOPGEN   3392
#define XCD_BAR_WORDS 3456
#define XB_SPIN_CAP (1u << 18)
DI unsigned xb_ld(unsigned* p)              { return __hip_atomic_load(p, __ATOMIC_RELAXED, __HIP_MEMORY_SCOPE_AGENT); }
DI unsigned xb_add(unsigned* p, unsigned v) { return __hip_atomic_fetch_add(p, v, __ATOMIC_RELAXED, __HIP_MEMORY_SCOPE_AGENT); }
DI unsigned xb_xcc_id() { return (unsigned)__builtin_amdgcn_s_getreg((3 << 11) | 20) & 0xFu; }
#define XB_SPIN(cond, bar) do { unsigned _sp = 0; while (cond) { __builtin_amdgcn_s_sleep(1); \
    if ((++_sp & 255u) == 0u) { if (xb_ld(&(bar)[XB_TMO])) break; if (_sp > XB_SPIN_CAP) { atomicAdd(&(bar)[XB_TMO], 1u); break; } } } } while (0)
struct XcdBarrier { unsigned* bar; unsigned x; volatile LAS unsigned* st; int wave; };
DI XcdBarrier xcd_barrier_post(unsigned* bar, volatile LAS unsigned* st, int wave) {
    XcdBarrier b; b.bar = bar; b.x = xb_xcc_id(); b.st = st; b.wave = wave;
    if (wave == 0 && fresh_lane() == 0) (void)xb_add(&bar[XB_XCNT(b.x)], 1u);
    return b;
}
DI void xcd_barrier_complete(unsigned* bar, unsigned x, unsigned& nloc, unsigned& nx) {
    const unsigned G = gridDim.x * gridDim.y * gridDim.z;
    unsigned sum, cnt, mine, sp = 0u;
    for (;;) {
        sum = 0u; cnt = 0u; mine = 0u;
#pragma unroll
        for (unsigned j = 0; j < 16; ++j) { const unsigned c = xb_ld(&bar[XB_XCNT(j)]); sum += c; cnt += (c > 0u) ? 1u : 0u; mine = (j == x) ? c : mine; }
        if (sum == G) break;
        __builtin_amdgcn_s_sleep(1);
        if ((++sp & 255u) == 0u) { if (xb_ld(&bar[XB_TMO])) break; if (sp > XB_SPIN_CAP) { atomicAdd(&bar[XB_TMO], 1u); break; } }
    }
    nloc = mine > 0u ? mine : 1u; nx = cnt > 0u ? cnt : 1u;
}
DI void xcd_barrier(const XcdBarrier& b) {
    asm volatile("s_waitcnt vmcnt(0)" ::: "memory");
    __syncthreads();
    if (b.wave == 0 && fresh_lane() == 0) {
        unsigned* bar = b.bar;
        __builtin_amdgcn_s_waitcnt(0);
        unsigned nloc = b.st[0], nx = b.st[1];
        if (nloc == 0u) { xcd_barrier_complete(bar, b.x, nloc, nx); b.st[0] = nloc; b.st[1] = nx; }
        const unsigned old = xb_add(&bar[XB_XSUB(b.x)], 1u);
        const unsigned gen = old / nloc;
        if (old + 1u == (gen + 1u) * nloc) {
            __builtin_amdgcn_fence(__ATOMIC_RELEASE, "agent");
            asm volatile("s_waitcnt vmcnt(0)" ::: "memory");
            const unsigned og = xb_add(&bar[XB_TOP], 1u);
            const unsigned tg = og / nx;
            if (og + 1u == (tg + 1u) * nx) xb_add(&bar[XB_TOPGEN], 1u);
            else XB_SPIN(xb_ld(&bar[XB_TOPGEN]) == tg, bar);
            __builtin_amdgcn_fence(__ATOMIC_ACQUIRE, "agent");
            xb_add(&bar[XB_XGEN(b.x)], 1u);
            asm volatile("s_waitcnt vmcnt(0)" ::: "memory");
        } else {
            XB_SPIN(xb_ld(&bar[XB_XGEN(b.x)]) == gen, bar);
            __builtin_amdgcn_fence(__ATOMIC_ACQUIRE, "agent");
            asm volatile("s_waitcnt vmcnt(0)" ::: "memory");
        }
    }
    __syncthreads();
}

namespace pg8 {
constexpr int BM = 256, BK = 64, HALF = 128, HTB = HALF * BK * 2, STAGE_BYTES = 8 * HTB, NXCD = 8, WGM = 8;
DI int lds_byte(int r, int c) { const int st = (r >> 4) * 2 + (c >> 5), rr = r & 15, cc = c & 31, ob = rr * 64 + cc * 2; return st * 1024 + (ob ^ (((ob >> 9) & 1) << 5)); }
DI void stage_rc(int b, int& R, int& C) { const int st = b / 1024, sb = b % 1024, swz = sb ^ (((sb >> 9) & 1) << 5); R = (st >> 1) * 16 + swz / 64; C = (st & 1) * 32 + (swz % 64) / 2; }
DI int perm32(int rho) { const int n = rho >> 4, i = rho & 15; return 8 * (i >> 2) + 4 * n + (i & 3); }

struct Unit { int pm, pn; gcc_t A; gcc_t B; };

struct DenseOrder {
    int nM, nN, nwg, G, c, K; gcc_t A; gcc_t B;
    DI void init(int M_, int N_, int K_, int G_, int c_, gcc_t A_, gcc_t B_) { nM = M_ / BM; nN = N_ / BM; nwg = nM * nN; G = G_; c = c_; K = K_; A = A_; B = B_; }
    DI bool next(int i, Unit& u) const {
        const long L = (long)i * G + c; if (L >= nwg) return false;
        int wgid = (int)L; { const int q = nwg / NXCD, r = nwg % NXCD, xcd = wgid % NXCD, off = wgid / NXCD; wgid = (xcd < r ? xcd * (q + 1) : r * (q + 1) + (xcd - r) * q) + off; }
        const int nig = WGM * nN, gid = wgid / nig, fm = gid * WGM, gsz = (nM - fm) < WGM ? (nM - fm) : WGM;
        u.pm = fm + ((wgid % nig) % gsz); u.pn = (wgid % nig) / gsz;
        u.A = A + (size_t)u.pm * BM * K * 2; u.B = B + (size_t)u.pn * BM * K * 2; return true;
    }
};
struct MoeOrder {
    int nunits, G, vc, K; gcc_t A; gcc_t B; size_t bstride; const LAS int* tend; bool gather;
    DI bool next(int i, Unit& u) const {
        const int L = i * G + vc; if (L >= nunits) return false;
        const int rt = L >> 2; u.pm = rt; u.pn = L & 3; int e = 0;
#pragma unroll
        for (int j = 0; j < 15; ++j) e += (tend[j] <= rt) ? 1 : 0;
        u.B = B + (size_t)e * bstride + (size_t)u.pn * BM * K * 2;
        u.A = gather ? A : A + (size_t)rt * BM * K * 2; return true;
    }
};

struct EpiQKV {
    static constexpr bool PERM = true;
    gb_t O; gcf_t qg; gcf_t kg; gcf_t rs; float qscale;
    DI void operator()(const f32x4 (&acc)[2][2][4][2], const Unit& u, int wr, int wc, int fr, int fq) const {
        const int row0 = u.pm * BM + wr * 64 + fr, colb = u.pn * BM + 64 * wc + 8 * fq;
        const bool nrm = u.pn < 8; gcf_t g = (u.pn < 4 ? qg : kg) + 8 * fq;
        f32x4 gv[2][2];
#pragma unroll
        for (int bj = 0; bj < 2; ++bj)
#pragma unroll
            for (int n = 0; n < 2; ++n) { gv[bj][n] = nrm ? *(const GAS f32x4*)(g + 32 * bj + 4 * n) : (f32x4){1.f, 1.f, 1.f, 1.f}; if (u.pn < 4) gv[bj][n] *= qscale; }
        float rsa[2][4];
#pragma unroll
        for (int ai = 0; ai < 2; ++ai)
#pragma unroll
            for (int m = 0; m < 4; ++m) rsa[ai][m] = rs[row0 + ai * HALF + m * 16];
        asm volatile("" : "+v"(rsa[0][0]), "+v"(rsa[0][1]), "+v"(rsa[0][2]), "+v"(rsa[0][3]), "+v"(rsa[1][0]), "+v"(rsa[1][1]), "+v"(rsa[1][2]), "+v"(rsa[1][3]));
        float ssr[8];
#pragma unroll
        for (int i = 0; i < 8; ++i) { float t = 0.f;
#pragma unroll
            for (int bj = 0; bj < 2; ++bj)
#pragma unroll
                for (int n = 0; n < 2; ++n) { const f32x4 q = acc[i >> 2][bj][i & 3][n] * acc[i >> 2][bj][i & 3][n]; t += (q[0] + q[1]) + (q[2] + q[3]); }
            ssr[i] = t; }
        if (nrm) {
#pragma unroll
            for (int i = 0; i < 8; ++i) ssr[i] += __shfl_xor(ssr[i], 16);
#pragma unroll
            for (int i = 0; i < 8; ++i) ssr[i] += __shfl_xor(ssr[i], 32);
        }
#pragma unroll
        for (int ai = 0; ai < 2; ++ai)
#pragma unroll
            for (int m = 0; m < 4; ++m) {
                const float rsv = rsa[ai][m];
                const float sc = nrm ? rsv * rsqrtf(rsv * rsv * ssr[ai * 4 + m] * (1.f / 64.f) + RMS_EPS) : rsv;
                gb_t rowp = O + (size_t)(row0 + ai * HALF + m * 16) * 3072 + colb;
#pragma unroll
                for (int bj = 0; bj < 2; ++bj) { const f32x4 a = acc[ai][bj][m][0] * sc * gv[bj][0], b = acc[ai][bj][m][1] * sc * gv[bj][1];
                    u32x4 w; w.x = cvtpk(a[0], a[1]); w.y = cvtpk(a[2], a[3]); w.z = cvtpk(b[0], b[1]); w.w = cvtpk(b[2], b[3]);
                    *(GAS u32x4*)(rowp + 32 * bj) = w; }
            }
    }
};
template <bool BASE16> struct EpiRes {
    static constexpr bool PERM = true;
    gcf_t base32; gcb_t base16; gb_t out;
    DI void operator()(const f32x4 (&acc)[2][2][4][2], const Unit& u, int wr, int wc, int fr, int fq) const {
        const int row0 = u.pm * BM + wr * 64 + fr, col0 = u.pn * BM + wc * 32 + 8 * fq;
        if constexpr (BASE16) {
            u32x4 r[2][4][2];
#pragma unroll
            for (int ai = 0; ai < 2; ++ai)
#pragma unroll
                for (int m = 0; m < 4; ++m)
#pragma unroll
                    for (int bj = 0; bj < 2; ++bj) r[ai][m][bj] = *(const GAS u32x4*)(base16 + (size_t)(row0 + ai * HALF + m * 16) * D + col0 + bj * HALF);
            asm volatile("" : "+v"(r[0][0][0]), "+v"(r[0][0][1]), "+v"(r[0][1][0]), "+v"(r[0][1][1]), "+v"(r[0][2][0]), "+v"(r[0][2][1]), "+v"(r[0][3][0]), "+v"(r[0][3][1]));
            asm volatile("" : "+v"(r[1][0][0]), "+v"(r[1][0][1]), "+v"(r[1][1][0]), "+v"(r[1][1][1]), "+v"(r[1][2][0]), "+v"(r[1][2][1]), "+v"(r[1][3][0]), "+v"(r[1][3][1]));
#pragma unroll
            for (int ai = 0; ai < 2; ++ai)
#pragma unroll
                for (int m = 0; m < 4; ++m) { const size_t off = (size_t)(row0 + ai * HALF + m * 16) * D + col0;
#pragma unroll
                    for (int bj = 0; bj < 2; ++bj) { const u32x4 rr = r[ai][m][bj];
                        const f32x4 b0 = (f32x4){bf2f((unsigned short)(rr.x & 0xffffu)), bf2f((unsigned short)(rr.x >> 16)), bf2f((unsigned short)(rr.y & 0xffffu)), bf2f((unsigned short)(rr.y >> 16))};
                        const f32x4 b1 = (f32x4){bf2f((unsigned short)(rr.z & 0xffffu)), bf2f((unsigned short)(rr.z >> 16)), bf2f((unsigned short)(rr.w & 0xffffu)), bf2f((unsigned short)(rr.w >> 16))};
                        const f32x4 v0 = b0 + acc[ai][bj][m][0], v1 = b1 + acc[ai][bj][m][1];
                        u32x4 w; w.x = cvtpk(v0[0], v0[1]); w.y = cvtpk(v0[2], v0[3]); w.z = cvtpk(v1[0], v1[1]); w.w = cvtpk(v1[2], v1[3]);
                        *(GAS u32x4*)(out + off + bj * HALF) = w; } }
        } else {
#pragma unroll
            for (int ai = 0; ai < 2; ++ai) {
#pragma unroll
                for (int m = 0; m < 4; ++m) { const size_t off = (size_t)(row0 + ai * HALF + m * 16) * D + col0;
#pragma unroll
                    for (int bj = 0; bj < 2; ++bj) { const f32x4 b0 = *(const GAS f32x4*)(base32 + off + bj * HALF), b1 = *(const GAS f32x4*)(base32 + off + bj * HALF + 4);
                        const f32x4 v0 = b0 + acc[ai][bj][m][0], v1 = b1 + acc[ai][bj][m][1];
                        u32x4 w; w.x = cvtpk(v0[0], v0[1]); w.y = cvtpk(v0[2], v0[3]); w.z = cvtpk(v1[0], v1[1]); w.w = cvtpk(v1[2], v1[3]);
                        *(GAS u32x4*)(out + off + bj * HALF) = w; } }
            }
        }
    }
};
struct EpiGateUp {
    static constexpr bool PERM = true;
    gb_t H; gcf_t srs;
    DI void operator()(const f32x4 (&acc)[2][2][4][2], const Unit& u, int wr, int wc, int fr, int fq) const {
        const int row0 = u.pm * BM + wr * 64 + fr, col0 = u.pn * 128 + wc * 32 + 8 * fq;
        float rsa[2][4];
#pragma unroll
        for (int ai = 0; ai < 2; ++ai)
#pragma unroll
            for (int m = 0; m < 4; ++m) rsa[ai][m] = srs[row0 + ai * HALF + m * 16];
        asm volatile("" : "+v"(rsa[0][0]), "+v"(rsa[0][1]), "+v"(rsa[0][2]), "+v"(rsa[0][3]), "+v"(rsa[1][0]), "+v"(rsa[1][1]), "+v"(rsa[1][2]), "+v"(rsa[1][3]));
#pragma unroll
        for (int ai = 0; ai < 2; ++ai)
#pragma unroll
            for (int m = 0; m < 4; ++m) { float hv[8]; const float rsv = rsa[ai][m];
#pragma unroll
                for (int n = 0; n < 2; ++n)
#pragma unroll
                    for (int i = 0; i < 4; ++i) { const float gvv = acc[ai][0][m][n][i] * rsv; hv[4 * n + i] = gvv * __builtin_amdgcn_rcpf(1.f + __builtin_amdgcn_exp2f(-gvv * LOG2E)) * (acc[ai][1][m][n][i] * rsv); }
                u32x4 w; w.x = cvtpk(hv[0], hv[1]); w.y = cvtpk(hv[2], hv[3]); w.z = cvtpk(hv[4], hv[5]); w.w = cvtpk(hv[6], hv[7]);
                *(GAS u32x4*)(H + (size_t)(row0 + ai * HALF + m * 16) * DE + col0) = w; }
    }
};
struct EpiBf16 {
    static constexpr bool PERM = true;
    gb_t O; int ldc;
    DI void operator()(const f32x4 (&acc)[2][2][4][2], const Unit& u, int wr, int wc, int fr, int fq) const {
        const int row0 = u.pm * BM + wr * 64 + fr, col0 = u.pn * BM + wc * 32 + 8 * fq;
#pragma unroll
        for (int ai = 0; ai < 2; ++ai)
#pragma unroll
            for (int m = 0; m < 4; ++m) { gb_t rowp = O + (size_t)(row0 + ai * HALF + m * 16) * ldc + col0;
#pragma unroll
                for (int bj = 0; bj < 2; ++bj) { const f32x4 v0 = acc[ai][bj][m][0], v1 = acc[ai][bj][m][1];
                    u32x4 w; w.x = cvtpk(v0[0], v0[1]); w.y = cvtpk(v0[2], v0[3]); w.z = cvtpk(v1[0], v1[1]); w.w = cvtpk(v1[2], v1[3]);
                    *(GAS u32x4*)(rowp + bj * HALF) = w; } }
    }
};

template <class Epi, class Sched, bool GATHER>
DI void gemm_phase(const int tid, LAS unsigned char* lds, const int K, const Sched& S, const Epi& E, const LAS int* rows_lds) {
    const int wid = __builtin_amdgcn_readfirstlane(tid >> 6), lane = tid & 63, wr = wid >> 2, wc = wid & 3, fr = lane & 15, fq = lane >> 4;
    const int nt = K / BK;
    unsigned voffA[2], voffB[2]; int R0 = 0, C0 = 0;
#pragma unroll
    for (int i = 0; i < 2; ++i) { int R, C; stage_rc(tid * 16 + i * 8192, R, C); const int Rb = Epi::PERM ? ((R & ~31) + perm32(R & 31)) : R;
        voffA[i] = (unsigned)(R * K + C) * 2u; voffB[i] = (unsigned)(Rb * K + C) * 2u; if (i == 0) { R0 = R; C0 = C; } }
    const size_t kstep = (size_t)(BK * 2);
    const size_t hstep = (size_t)HALF * K * 2;
    const unsigned ldsw = (unsigned)wid * 1024u;
    const int aoff = lds_byte(wr * 64 + fr, fq * 8), boff = lds_byte(wc * 32 + fr, fq * 8);
#define PG8_SA(b, h) (((b) * 2 + (h)) * HTB)
#define PG8_SB(b, h) ((4 + (b) * 2 + (h)) * HTB)
#define PG8_STAGE(bufoff, gbase, voff) do { _Pragma("unroll") for (int _i = 0; _i < 2; ++_i) \
        __builtin_amdgcn_global_load_lds((const GAS unsigned*)((gcc_t)(gbase) + (voff)[_i]), (LAS unsigned*)(lds + (bufoff) + ldsw + _i * 8192), 16, 0, 0); } while (0)
#define PG8_STAGE_A(bufoff, kbase, h, GV) do { if constexpr (GATHER) { PG8_STAGE(bufoff, kbase, GV[h]); } else { PG8_STAGE(bufoff, (kbase) + (h) * hstep, voffA); } } while (0)
#define PG8_LDA(dst, b, h) do { _Pragma("unroll") for (int m = 0; m < 4; ++m) _Pragma("unroll") for (int k = 0; k < 2; ++k) dst[m][k] = *(const LAS bf16x8*)(lds + PG8_SA(b, h) + aoff + m * 2048 + k * 1024); } while (0)
#define PG8_LDB(dst, b, h) do { _Pragma("unroll") for (int n = 0; n < 2; ++n) _Pragma("unroll") for (int k = 0; k < 2; ++k) dst[n][k] = *(const LAS bf16x8*)(lds + PG8_SB(b, h) + boff + n * 2048 + k * 1024); } while (0)
#define PG8_MMA(ai, bj, At, Bt) do { __builtin_amdgcn_s_setprio(1); _Pragma("unroll") for (int m = 0; m < 4; ++m) _Pragma("unroll") for (int n = 0; n < 2; ++n) _Pragma("unroll") for (int k = 0; k < 2; ++k) \
        acc[ai][bj][m][n] = __builtin_amdgcn_mfma_f32_16x16x32_bf16(Bt[n][k], At[m][k], acc[ai][bj][m][n], 0, 0, 0); __builtin_amdgcn_s_setprio(0); } while (0)
#define PG8_WAIT_V(n) asm volatile("s_waitcnt vmcnt(" #n ")" ::: "memory")
#define PG8_WAIT_L(n) asm volatile("s_waitcnt lgkmcnt(" #n ")" ::: "memory")
#define PG8_BAR __builtin_amdgcn_s_barrier()
#define PG8_SCHED __builtin_amdgcn_sched_barrier(0)
#define PG8_ROWS(dst, ui_) do { int R0_, C0_; stage_rc((wid * 64 + fresh_lane()) * 16, R0_, C0_); _Pragma("unroll") for (int _h = 0; _h < 2; ++_h) _Pragma("unroll") for (int _j = 0; _j < 2; ++_j) \
        dst[_h][_j] = (unsigned)(rows_lds[(ui_) * 256 + _h * 128 + R0_ + 64 * _j] * K + C0_) * 2u; } while (0)
    Unit cur, nxt; int ui = 0;
    if (!S.next(0, cur)) return;
    f32x4 acc[2][2][4][2];
#pragma unroll
    for (int a = 0; a < 2; ++a)
#pragma unroll
        for (int b = 0; b < 2; ++b)
#pragma unroll
            for (int m = 0; m < 4; ++m)
#pragma unroll
                for (int n = 0; n < 2; ++n) acc[a][b][m][n] = (f32x4){0.f, 0.f, 0.f, 0.f};
    bf16x8 At[4][2], B0[2][2], B1[2][2];
    gcc_t cA = cur.A; gcc_t cB = cur.B;
    unsigned gC[2][2] = {{0u, 0u}, {0u, 0u}}, gN[2][2] = {{0u, 0u}, {0u, 0u}};
    if constexpr (GATHER) { PG8_ROWS(gC, 0); }
    PG8_STAGE(PG8_SB(0, 0), cB, voffB); PG8_STAGE(PG8_SB(0, 1), cB + hstep, voffB); PG8_STAGE_A(PG8_SA(0, 0), cA, 0, gC); PG8_STAGE_A(PG8_SA(0, 1), cA, 1, gC);
    if (wr == 1) PG8_BAR;
    PG8_WAIT_V(2); PG8_BAR;
    PG8_STAGE(PG8_SB(1, 0), cB + kstep, voffB); PG8_STAGE_A(PG8_SA(1, 0), cA + kstep, 0, gC); PG8_STAGE(PG8_SB(1, 1), cB + hstep + kstep, voffB);
    PG8_WAIT_V(6); PG8_BAR;
    for (;;) {
        const bool has_next = S.next(ui + 1, nxt);
        gcc_t nA = has_next ? nxt.A : cA; gcc_t nB = has_next ? nxt.B : cB;
        if constexpr (GATHER) { if (has_next) { PG8_ROWS(gN, ui + 1); } else {
#pragma unroll
            for (int h = 0; h < 2; ++h)
#pragma unroll
                for (int j = 0; j < 2; ++j) gN[h][j] = gC[h][j]; } }
        for (int t = 0; t < nt; t += 2) {
            const bool last = (t == nt - 2);
            gcc_t a1 = cA + (size_t)(t + 1) * kstep;
            gcc_t a2 = last ? nA : cA + (size_t)(t + 2) * kstep; gcc_t b2 = last ? nB : cB + (size_t)(t + 2) * kstep;
            gcc_t a3 = a2 + kstep; gcc_t b3 = b2 + kstep;
            unsigned g2[2][2];
#pragma unroll
            for (int h = 0; h < 2; ++h)
#pragma unroll
                for (int j = 0; j < 2; ++j) g2[h][j] = last ? gN[h][j] : gC[h][j];
            PG8_LDB(B0, 0, 0); PG8_LDB(B1, 0, 1); PG8_SCHED; PG8_LDA(At, 0, 0); PG8_STAGE_A(PG8_SA(1, 1), a1, 1, gC);
            PG8_WAIT_V(8); PG8_WAIT_L(0); PG8_BAR; PG8_MMA(0, 0, At, B0); PG8_MMA(0, 1, At, B1); PG8_BAR; PG8_SCHED;
            PG8_LDA(At, 0, 1); PG8_STAGE(PG8_SB(0, 0), b2, voffB); PG8_STAGE(PG8_SB(0, 1), b2 + hstep, voffB); PG8_STAGE_A(PG8_SA(0, 0), a2, 0, g2);
            PG8_WAIT_V(8); PG8_WAIT_L(0); PG8_BAR; PG8_MMA(1, 0, At, B0); PG8_MMA(1, 1, At, B1); PG8_BAR; PG8_SCHED;
            PG8_LDB(B0, 1, 0); PG8_LDB(B1, 1, 1); PG8_SCHED; PG8_LDA(At, 1, 0); PG8_STAGE_A(PG8_SA(0, 1), a2, 1, g2);
            PG8_WAIT_V(8); PG8_WAIT_L(0); PG8_BAR; PG8_MMA(0, 0, At, B0); PG8_MMA(0, 1, At, B1); PG8_BAR; PG8_SCHED;
            PG8_LDA(At, 1, 1); PG8_STAGE(PG8_SB(1, 0), b3, voffB); PG8_STAGE(PG8_SB(1, 1), b3 + hstep, voffB); PG8_STAGE_A(PG8_SA(1, 0), a3, 0, g2);
            PG8_WAIT_V(8); PG8_WAIT_L(0); PG8_BAR; PG8_MMA(1, 0, At, B0); PG8_MMA(1, 1, At, B1); PG8_BAR; PG8_SCHED;
        }
        if (wr == 0) PG8_BAR;
        E(acc, cur, wr, wc, fr, fq);
        if (!has_next) break;
#pragma unroll
        for (int a = 0; a < 2; ++a)
#pragma unroll
            for (int b = 0; b < 2; ++b)
#pragma unroll
                for (int m = 0; m < 4; ++m)
#pragma unroll
                    for (int n = 0; n < 2; ++n) acc[a][b][m][n] = (f32x4){0.f, 0.f, 0.f, 0.f};
        cur = nxt; cA = nA; cB = nB; ++ui;
        if constexpr (GATHER) {
#pragma unroll
            for (int h = 0; h < 2; ++h)
#pragma unroll
                for (int j = 0; j < 2; ++j) gC[h][j] = gN[h][j]; }
        if (wr == 1) PG8_BAR;
    }
    PG8_WAIT_V(0);
    PG8_BAR;
#undef PG8_SA
#undef PG8_SB
#undef PG8_STAGE
#undef PG8_STAGE_A
#undef PG8_LDA
#undef PG8_LDB
#undef PG8_MMA
#undef PG8_WAIT_V
#undef PG8_WAIT_L
#undef PG8_BAR
#undef PG8_SCHED
#undef PG8_ROWS
}
}

struct Args { const float* in[25]; float* out; unsigned char* ws; int ph_lo, ph_hi; };
struct Frame {
    LAS unsigned char* lds; volatile LAS unsigned* MISC; gu_t ctl;
    int tid, lane, wave, vcu, G, bx;
    guc_t ws;
};

DI int dst_row(int mode, int n) {
    if (mode == 1) { const int t = n >> 8, lc = n & 255; return t * 256 + 128 * ((lc >> 5) & 1) + 32 * (lc >> 6) + (lc & 31); }
    if (mode == 2) return (n >> 7) * 256 + (n & 127);
    if (mode == 3) return (n >> 7) * 256 + 128 + (n & 127);
    return n;
}
struct TrItem { gcf_t W; gb_t WT; gcf_t gain; int K, N, mode, item; };
DI void tr_load(const TrItem& t, float (&wv)[32], float& g0, int lane) {
    const int nblk = t.N / 32, kb = t.item / nblk, nb = t.item % nblk, k0 = 64 * kb, n0 = 32 * nb;
#pragma unroll
    for (int i = 0; i < 32; ++i) { const int kk = 2 * i + (lane >> 5); wv[i] = __builtin_nontemporal_load(&t.W[(size_t)(k0 + kk) * t.N + n0 + (lane & 31)]); }
    { gcf_t gp = t.gain ? t.gain : t.W; g0 = gp[k0 + lane]; }
}
DI void tr_store(const TrItem& t, const float (&wv)[32], float g0, LAS float* scr, int lane) {
    const int nblk = t.N / 32, kb = t.item / nblk, nb = t.item % nblk, k0 = 64 * kb, n0 = 32 * nb;
    const float g1 = t.gain ? g0 : 1.f;
#pragma unroll
    for (int i = 0; i < 32; ++i) { const int kk = 2 * i + (lane >> 5); const float gk = __builtin_bit_cast(float, __builtin_amdgcn_ds_bpermute(kk * 4, __builtin_bit_cast(int, g1))); scr[kk * 33 + (lane & 31)] = wv[i] * gk; }
    asm volatile("s_waitcnt lgkmcnt(0)" ::: "memory");
    const int c = lane & 7;
#pragma unroll
    for (int j = 0; j < 4; ++j) { const int n = (lane >> 3) + 8 * j; const LAS float* sp = scr + (8 * c) * 33 + n;
        u32x4 o; o.x = cvtpk(sp[0 * 33], sp[1 * 33]); o.y = cvtpk(sp[2 * 33], sp[3 * 33]); o.z = cvtpk(sp[4 * 33], sp[5 * 33]); o.w = cvtpk(sp[6 * 33], sp[7 * 33]);
        __builtin_nontemporal_store(o, (GAS u32x4*)(t.WT + (size_t)dst_row(t.mode, n0 + n) * t.K + k0 + 8 * c)); }
    asm volatile("s_waitcnt lgkmcnt(0)" ::: "memory");
}
DI TrItem conv_decode(const Frame& F, const Args& a, int L, int it) {
    const int j = L >> 1; const bool is_na = !(L & 1);
    constexpr int I_QKV = 16 * 96, I_O = 16 * 32, I_G = 16 * 256;
    TrItem t; int r = it;
    if (r < I_QKV) { t.W = (gcf_t)a.in[is_na ? 3 : 8] + (size_t)j * 1024 * 3072; t.WT = (gb_t)(F.ws + WS_WQKVP); t.gain = (gcf_t)a.in[1] + L * 1024; t.K = 1024; t.N = 3072; t.mode = 1; t.item = r; return t; } r -= I_QKV;
    if (r < I_O) { t.W = (gcf_t)a.in[is_na ? 4 : 9] + (size_t)j * 1024 * 1024; t.WT = (gb_t)(F.ws + WS_WO); t.gain = (gcf_t)nullptr; t.K = 1024; t.N = 1024; t.mode = 0; t.item = r; return t; } r -= I_O;
    if (r < 2 * I_G) { const int up = r >= I_G; r -= up * I_G; const int e = r >> 8;
        t.W = (gcf_t)a.in[22 + up] + (size_t)L * 16 * 1024 * 512 + (size_t)e * 1024 * 512; t.WT = (gb_t)(F.ws + WS_WGU) + (size_t)e * 1024 * 1024; t.gain = (gcf_t)a.in[2] + L * 1024; t.K = 1024; t.N = 512; t.mode = 2 + up; t.item = r & 255; return t; }
    r -= 2 * I_G;
    { const int e = r >> 8; t.W = (gcf_t)a.in[24] + (size_t)L * 16 * 512 * 1024 + (size_t)e * 512 * 1024; t.WT = (gb_t)(F.ws + WS_WD) + (size_t)e * 1024 * 512; t.gain = (gcf_t)nullptr; t.K = 512; t.N = 1024; t.mode = 0; t.item = r & 255; return t; }
}
DI void convert_layer(const Frame& F, const Args& a, int L) {
    LAS float* scr = (LAS float*)(F.lds + F.wave * 16384);
    const int gw = F.vcu * NWAVES + F.wave, NGW = F.G * NWAVES;
    constexpr int NITEMS = 16 * 96 + 16 * 32 + 3 * 16 * 256;
    int it = gw; if (it >= NITEMS) return;
    TrItem ta = conv_decode(F, a, L, it), tb = ta; float va[32], vb[32], ga, gb;
    tr_load(ta, va, ga, F.lane);
    for (;;) {
        const bool hb = it + NGW < NITEMS;
        if (hb) { tb = conv_decode(F, a, L, it + NGW); tr_load(tb, vb, gb, F.lane); }
        tr_store(ta, va, ga, scr, F.lane);
        if (!hb) break;
        it += NGW;
        const bool ha = it + NGW < NITEMS;
        if (ha) { ta = conv_decode(F, a, L, it + NGW); tr_load(ta, va, ga, F.lane); }
        tr_store(tb, vb, gb, scr, F.lane);
        if (!ha) break;
        it += NGW;
    }
}
DI void stream_load(gcf_t xrow, f32x4 (&v)[4], int lane) {
    const GAS f32x4* xr = (const GAS f32x4*)xrow + lane;
#pragma unroll
    for (int j = 0; j < 4; ++j) v[j] = xr[64 * j];
}
DI void stream_store(const f32x4 (&v)[4], gb_t orow, gf_t rs, int lane) {
    float s = 0.f;
#pragma unroll
    for (int j = 0; j < 4; ++j) s += (v[j].x * v[j].x + v[j].y * v[j].y) + (v[j].z * v[j].z + v[j].w * v[j].w);
    const float r = rsqrtf(wave_sum(s) * (1.f / D) + RMS_EPS);
    GAS u32x2* o = (GAS u32x2*)orow + lane;
#pragma unroll
    for (int j = 0; j < 4; ++j) { u32x2 w; w.x = cvtpk(v[j].x, v[j].y); w.y = cvtpk(v[j].z, v[j].w); o[64 * j] = w; }
    if (lane == 0) *rs = r;
}

DI void glds16(const GAS void* gsrc, unsigned lds_dst) { unsigned keep;
    asm volatile("s_mov_b32 %0, m0\n\ts_mov_b32 m0, %2\n\ts_nop 0\n\tglobal_load_lds_dwordx4 %1, off\n\ts_mov_b32 m0, %0" : "=&s"(keep) : "v"(gsrc), "s"(lds_dst) : "memory"); }
#define ATT_WAIT_BAR() asm volatile("s_waitcnt vmcnt(0) lgkmcnt(0)\n\ts_barrier" ::: "memory")
DI int crow(int r, int hi) { return (r & 3) + 8 * (r >> 2) + 4 * hi; }
DI s16x4 vtr(const LAS char* p) { return __builtin_bit_cast(s16x4, __builtin_amdgcn_ds_read_tr16_b64_v4i16((LAS s16x4*)p)); }
DI bf16x8 pack8(const f32x16& x, int s) {
    u32x4 p; p.x = cvtpk(x[8 * s], x[8 * s + 1]); p.y = cvtpk(x[8 * s + 2], x[8 * s + 3]); p.z = cvtpk(x[8 * s + 4], x[8 * s + 5]); p.w = cvtpk(x[8 * s + 6], x[8 * s + 7]);
    return __builtin_bit_cast(bf16x8, p);
}
#define MFMA32(a, b, c) __builtin_amdgcn_mfma_f32_32x32x16_bf16((a), (b), (c), 0, 0, 0)

DI void glds16s(const GAS void* sbase, unsigned voff, unsigned lds_dst) { unsigned keep;
    asm volatile("s_mov_b32 %0, m0\n\ts_mov_b32 m0, %3\n\ts_nop 0\n\tglobal_load_lds_dwordx4 %1, %2\n\ts_mov_b32 m0, %0" : "=&s"(keep) : "v"(voff), "s"(sbase), "s"(lds_dst) : "memory"); }
DI void glds16s_pair(const GAS void* sbase, unsigned voff, unsigned dst0, unsigned dst1m) { unsigned keep;
    asm volatile("s_mov_b32 %0, m0\n\ts_mov_b32 m0, %3\n\ts_nop 0\n\tglobal_load_lds_dwordx4 %1, %2\n\ts_mov_b32 m0, %4\n\ts_nop 0\n\tglobal_load_lds_dwordx4 %1, %2 offset:128\n\ts_mov_b32 m0, %0"
                 : "=&s"(keep) : "v"(voff), "s"(sbase), "s"(dst0), "s"(dst1m) : "memory"); }
DI void glds16s_kv(const GAS void* sbase, unsigned voffk, unsigned voffv, unsigned dstk, unsigned dstvm) { unsigned keep;
    asm volatile("s_mov_b32 %0, m0\n\ts_mov_b32 m0, %3\n\ts_nop 0\n\tglobal_load_lds_dwordx4 %1, %2\n\ts_mov_b32 m0, %4\n\ts_nop 0\n\tglobal_load_lds_dwordx4 %5, %2 offset:2048\n\ts_mov_b32 m0, %0"
                 : "=&s"(keep) : "v"(voffk), "s"(sbase), "s"(dstk), "s"(dstvm), "v"(voffv) : "memory"); }
DI void na_wait_bar(int n) {
    if (n >= 12) asm volatile("s_waitcnt vmcnt(12) lgkmcnt(0)\n\ts_barrier" ::: "memory");
    else if (n >= 8) asm volatile("s_waitcnt vmcnt(8) lgkmcnt(0)\n\ts_barrier" ::: "memory");
    else if (n >= 4) asm volatile("s_waitcnt vmcnt(4) lgkmcnt(0)\n\ts_barrier" ::: "memory");
    else if (n >= 2) asm volatile("s_waitcnt vmcnt(2) lgkmcnt(0)\n\ts_barrier" ::: "memory");
    else asm volatile("s_waitcnt vmcnt(0) lgkmcnt(0)\n\ts_barrier" ::: "memory");
}
DI void na_phase(const Frame& F, gcb_t QKV, gcf_t rpb, gcf_t qg, gcf_t kg, gb_t AO) {
    const int w = F.wave;
    LAS char* const L0 = (LAS char*)F.lds;
    LAS float* const TBL = (LAS float*)(L0 + 65536);
    LAS float* const wsc = (LAS float*)(L0 + 67584) + w * 64;
    const unsigned lds0 = (unsigned)(uintptr_t)L0;
    const float shift = uni(8.f * wave_max(fabsf(qg[F.lane])) * wave_max(fabsf(kg[F.lane])));
    const float c1 = 0.125f * LOG2E;
    constexpr int NU = BATCH * 16 * 16;
    ATT_WAIT_BAR();
    if (F.vcu >= NU) { ATT_WAIT_BAR(); return; }
    int wl = w; asm volatile("" : "+s"(wl));
    const int lane = fresh_lane(), r32 = lane & 31, hi = lane >> 5, tid = wl * 64 + lane;
    const int c0 = 16 * (wl & 3), c = c0 + (r32 & 15);
    int kstart = c0 - 8; kstart = kstart < 0 ? 0 : (kstart > 32 ? 32 : kstart);
    int cs = c - 8; cs = cs < 0 ? 0 : (cs > 48 ? 48 : cs);
    const int dl = kstart + 4 * hi - cs;
    const unsigned kvo = (unsigned)lane * 6144u + (unsigned)wl * 16u;
    const unsigned vvo = (unsigned)(16 * (wl & 3) + (lane >> 2)) * 6144u + (unsigned)(wl >> 2) * 64u + (unsigned)(lane & 3) * 16u;
    const unsigned kdst = lds0 + wl * 1024;
    int va[4];
#pragma unroll
    for (int j = 0; j < 4; ++j) { const int row = kstart + 4 * hi + ((lane & 15) >> 2) + 8 * j; va[j] = (row >> 4) * 1024 + (row & 15) * 64 + ((lane >> 4) & 1) * 32 + (lane & 3) * 8; }
#define NA_GEOM(u_, b_, h_, R0_, klo_, khi_) const int b_ = (u_) >> 8, h_ = ((u_) >> 4) & 15, R0_ = 4 * ((u_) & 15); \
        int klo_ = R0_ - 4; klo_ = klo_ < 0 ? 0 : klo_; int khi_ = R0_ + 3 - 4; khi_ = (khi_ < 0 ? 0 : (khi_ > 56 ? 56 : khi_)) + 7
#define NA_KBASE(b_, h_) (QKV + (size_t)(b_) * SEQ * 3072 + 1024 + (h_) * 64)
#define NA_DMA(kb_, kr_, gs_) do { const unsigned d_ = (unsigned)__builtin_amdgcn_readfirstlane(kdst + (unsigned)(((gs_) & 3) * 16384)); const unsigned long long p_ = (unsigned long long)((kb_) + (size_t)(kr_) * 64 * 3072); \
        const unsigned plo_ = (unsigned)__builtin_amdgcn_readfirstlane((int)(unsigned)p_), phi_ = (unsigned)__builtin_amdgcn_readfirstlane((int)(unsigned)(p_ >> 32)); \
        glds16s_kv((const GAS void*)(((unsigned long long)phi_ << 32) | plo_), kvo, vvo, d_, d_ + (8192u - 2048u)); } while (0)
#define NA_LOADQ(dst, b_, h_, R0_) do { const int r_ = (R0_) + 2 * (wl >> 2) + (r32 >> 4); gcb_t qp = QKV + ((size_t)(b_) * SEQ + r_ * 64 + c) * 3072 + (h_) * 64 + hi * 8; \
        _Pragma("unroll") for (int d0 = 0; d0 < 4; ++d0) dst[d0] = *(const GAS bf16x8*)(qp + d0 * 16); } while (0)
    int u = F.vcu, gst = 0, h_tbl = -1; bool first = true;
    bf16x8 qf[4], qn[4];
    { NA_GEOM(u, b0_, h0_, R00_, kl0_, kh0_); (void)kh0_;
      for (int idx = tid; idx < 15 * 31; idx += NTHREADS) TBL[idx] = (rpb[h0_ * 465 + idx] - shift) * LOG2E;
      h_tbl = h0_;
      NA_LOADQ(qf, b0_, h0_, R00_);
      asm volatile("" : "+v"(qf[0]), "+v"(qf[1]), "+v"(qf[2]), "+v"(qf[3]));
      gcb_t kb0 = NA_KBASE(b0_, h0_);
      NA_DMA(kb0, kl0_, 0); NA_DMA(kb0, kl0_ + 1, 1); NA_DMA(kb0, kl0_ + 2, 2); }
    for (;;) {
        NA_GEOM(u, b, h, R0, kr_lo, kr_hi);
        const int un = u + F.G; const bool has_next = un < NU;
        NA_GEOM(has_next ? un : u, bn, hn, R0n, kn_lo, kn_hi); (void)kn_hi;
        gcb_t kbase = NA_KBASE(b, h); gcb_t kbasen = NA_KBASE(bn, hn);
        const int r0 = R0 + 2 * (wl >> 2);
        int wlo = r0 - 4; wlo = wlo < 0 ? 0 : (wlo > 56 ? 56 : wlo); int whi = r0 + 1 - 4; whi = (whi < 0 ? 0 : (whi > 56 ? 56 : whi)) + 7;
        const int r = r0 + (r32 >> 4);
        int rs = r - 4; rs = rs < 0 ? 0 : (rs > 56 ? 56 : rs);
        const LAS char* const tb0 = (const LAS char*)TBL + ((7 - r) * 31 + 15 - c + kstart + 4 * hi) * 4;
        const int nst = first ? 0 : 4;
        float l = 0.f; f32x16 o0 = {}, o1 = {};
        for (int kr = kr_lo; kr <= kr_hi; ++kr, ++gst) {
            const int st = kr - kr_lo, slot = (gst & 3) * 16384, rem = kr_hi - kr;
            int allow = 4;
            if (st == 0) allow = 4 + nst; else if (st == 1 || st == 2) allow = 4 + nst; else if (st == 5 || st == 6) allow = has_next ? 8 : 4;
            if (!has_next) { if (rem == 1) allow = 2; else if (rem == 0) allow = 0; }
            na_wait_bar(allow);
            if (st == 4 && has_next) {
                const int r_ = R0n + 2 * (wl >> 2) + (r32 >> 4); gcb_t qp = QKV + ((size_t)bn * SEQ + r_ * 64 + c) * 3072 + hn * 64 + hi * 8;
                asm volatile("global_load_dwordx4 %0, %4, off\n\tglobal_load_dwordx4 %1, %4, off offset:32\n\tglobal_load_dwordx4 %2, %4, off offset:64\n\tglobal_load_dwordx4 %3, %4, off offset:96"
                             : "=&v"(qn[0]), "=&v"(qn[1]), "=&v"(qn[2]), "=&v"(qn[3]) : "v"(qp) : "memory"); }
            if (rem >= 3) NA_DMA(kbase, kr + 3, gst + 3); else if (has_next) NA_DMA(kbasen, kn_lo + (2 - rem), gst + 3);
            if (kr >= wlo && kr <= whi) {
                const LAS char* Kb = L0 + slot + hi * 1024 + (kstart + r32) * 16; const LAS char* Vb = L0 + slot + 8192;
                const LAS char* tb = tb0 + kr * 124;
                bf16x8 kf[4];
#pragma unroll
                for (int d0 = 0; d0 < 4; ++d0) kf[d0] = *(const LAS bf16x8*)(Kb + d0 * 2048);
                float tv[16];
#pragma unroll
                for (int i = 0; i < 16; ++i) tv[i] = *(const LAS float*)(tb + ((i & 3) + 8 * (i >> 2)) * 4);
                s16x4 vl[8];
#pragma unroll
                for (int j = 0; j < 4; ++j) { vl[2 * j] = vtr(Vb + va[j]); vl[2 * j + 1] = vtr(Vb + 4096 + va[j]); }
                __builtin_amdgcn_sched_barrier(0);
                f32x16 s0 = {};
#pragma unroll
                for (int d0 = 0; d0 < 4; ++d0) s0 = MFMA32(kf[d0], qf[d0], s0);
                __builtin_amdgcn_sched_barrier(0);
                asm volatile("" : "+v"(tv[0]), "+v"(tv[1]), "+v"(tv[2]), "+v"(tv[3]), "+v"(tv[4]), "+v"(tv[5]), "+v"(tv[6]), "+v"(tv[7]));
                asm volatile("" : "+v"(tv[8]), "+v"(tv[9]), "+v"(tv[10]), "+v"(tv[11]), "+v"(tv[12]), "+v"(tv[13]), "+v"(tv[14]), "+v"(tv[15]));
                const bool rowok = (unsigned)(kr - rs) < 8u;
                float ls = 0.f;
#pragma unroll
                for (int i = 0; i < 16; ++i) { const int ko = (i & 3) + 8 * (i >> 2);
                    const bool ok = rowok && ((unsigned)(dl + ko) < 16u); float p = __builtin_amdgcn_exp2f(s0[i] * c1 + tv[i]); asm volatile("" : "+v"(p)); p = ok ? p : 0.f; s0[i] = p; ls += p; }
                l += ls;
                const bf16x8 pa0 = pack8(s0, 0), pa1 = pack8(s0, 1);
                o0 = MFMA32(pa0, __builtin_shufflevector(vl[0], vl[2], 0, 1, 2, 3, 4, 5, 6, 7), o0);
                o1 = MFMA32(pa0, __builtin_shufflevector(vl[1], vl[3], 0, 1, 2, 3, 4, 5, 6, 7), o1);
                o0 = MFMA32(pa1, __builtin_shufflevector(vl[4], vl[6], 0, 1, 2, 3, 4, 5, 6, 7), o0);
                o1 = MFMA32(pa1, __builtin_shufflevector(vl[5], vl[7], 0, 1, 2, 3, 4, 5, 6, 7), o1);
            }
        }
        wsc[hi * 32 + r32] = l;
        asm volatile("s_waitcnt lgkmcnt(0)" ::: "memory");
        LAS unsigned short* stg = (LAS unsigned short*)(L0 + 69632 + w * 4096) + hi * 4 * 64 + r32;
#pragma unroll
        for (int i = 0; i < 16; ++i) { const int q = crow(i, hi); const float rl = __builtin_amdgcn_rcpf(wsc[q] + wsc[32 + q]);
            stg[((i & 3) + 8 * (i >> 2)) * 64] = (unsigned short)(cvtpk(o0[i] * rl, 0.f) & 0xffffu); stg[((i & 3) + 8 * (i >> 2)) * 64 + 32] = (unsigned short)(cvtpk(o1[i] * rl, 0.f) & 0xffffu); }
        asm volatile("s_waitcnt lgkmcnt(0)" ::: "memory");
        { gcc_t ob_ = (gcc_t)(AO + ((size_t)b * SEQ + r0 * 64 + c0) * 1024 + h * 64);
          const LAS char* sp = L0 + 69632 + w * 4096 + lane * 16;
#pragma unroll
          for (int jj = 0; jj < 4; ++jj) { const u32x4 val = *(const LAS u32x4*)(sp + jj * 1024);
              const unsigned vo = (unsigned)((jj >> 1) * 64 + 8 * (jj & 1) + (lane >> 3)) * 2048u + (unsigned)(lane & 7) * 16u;
              *(GAS u32x4*)(ob_ + vo) = val; } }
        if (!has_next) break;
        if (hn != h_tbl) {
            ATT_WAIT_BAR();
            for (int idx = tid; idx < 15 * 31; idx += NTHREADS) TBL[idx] = (rpb[hn * 465 + idx] - shift) * LOG2E;
            h_tbl = hn; ATT_WAIT_BAR(); }
#pragma unroll
        for (int d0 = 0; d0 < 4; ++d0) qf[d0] = qn[d0];
        u = un; first = false;
    }
#undef NA_GEOM
#undef NA_KBASE
#undef NA_DMA
#undef NA_LOADQ
    ATT_WAIT_BAR();
}

DI int t5_bucket(int rel) { const int n = rel < 0 ? -rel : rel; int bk;
    if (n < 8) bk = n; else bk = 8 + (n >= 12) + (n >= 16) + (n >= 23) + (n >= 32) + (n >= 46) + (n >= 64) + (n >= 91);
    return bk + (rel > 0 ? 16 : 0); }
DI void diff_epilogue(const f32x16 (&oa)[4], const f32x16 (&ob)[4], LAS float* wsc, float lam, float oml, gcf_t subg, LAS char* L0, int w, gb_t AO, size_t tokb, int qw0, int h) {
    const int lane = fresh_lane(), r32 = lane & 31, hi = lane >> 5;
        float sg[4];
#pragma unroll
        for (int db = 0; db < 4; ++db) sg[db] = subg[db * 32 + r32];
        asm volatile("" : "+v"(sg[0]), "+v"(sg[1]), "+v"(sg[2]), "+v"(sg[3]));
#pragma unroll
        for (int db = 0; db < 4; ++db) sg[db] *= oml;
        LAS unsigned short* stg = (LAS unsigned short*)(L0 + w * 8192) + hi * 4 * 128 + r32;
#pragma unroll
        for (int i = 0; i < 16; ++i) { const int qq = crow(i, hi); const float ra = __builtin_amdgcn_rcpf(wsc[qq] + wsc[32 + qq]), rbb = lam * __builtin_amdgcn_rcpf(wsc[64 + qq] + wsc[96 + qq]);
            float v[4]; float ss = 0.f;
#pragma unroll
            for (int db = 0; db < 4; ++db) { v[db] = oa[db][i] * ra - ob[db][i] * rbb; ss += v[db] * v[db]; }
            ss += SWZ_XOR(ss, 1); ss += SWZ_XOR(ss, 2); ss += SWZ_XOR(ss, 4); ss += SWZ_XOR(ss, 8); ss += SWZ_XOR(ss, 16);
            const float rn = rsqrtf(ss * (1.f / 128.f) + RMS_EPS);
#pragma unroll
            for (int db = 0; db < 4; ++db) stg[((i & 3) + 8 * (i >> 2)) * 128 + db * 32] = (unsigned short)(cvtpk(v[db] * rn * sg[db], 0.f) & 0xffffu);
            __builtin_amdgcn_sched_barrier(0); }
        asm volatile("s_waitcnt lgkmcnt(0)" ::: "memory");
        { gcc_t ob_ = (gcc_t)(AO + (tokb + qw0) * 1024 + h * 128);
          const unsigned vo = (unsigned)(lane >> 4) * 2048u + (unsigned)(lane & 15) * 16u;
          const LAS char* sp = L0 + w * 8192 + lane * 16;
#pragma unroll
          for (int jj = 0; jj < 8; ++jj) { const u32x4 val = *(const LAS u32x4*)(sp + jj * 1024); *(GAS u32x4*)(ob_ + (size_t)jj * 8192 + vo) = val; } }
}
DI void diff_phase(const Frame& F, gcb_t QKV, gcf_t rel_bias, gcf_t qg, gcf_t kg, gcf_t lq1, gcf_t lk1, gcf_t lq2, gcf_t lk2,
                   gcf_t subg, float lambda_init, gb_t AO) {
    const int w = F.wave;
    LAS char* const L0 = (LAS char*)F.lds;
    LAS float* const TBL = (LAS float*)(L0 + ROWS_OFF);
    LAS float* const wsc = (LAS float*)(L0 + ROWS_OFF + 2048) + w * 128;
    const unsigned lds0 = (unsigned)(uintptr_t)L0;
    float shift, lam;
    { const int lane = F.lane;
    float mb = fmaxf(fmaxf(fabsf(rel_bias[lane]), fabsf(rel_bias[64 + lane])), fmaxf(fabsf(rel_bias[128 + lane]), fabsf(rel_bias[192 + lane])));
    shift = uni(8.f * wave_max(fabsf(qg[lane])) * wave_max(fabsf(kg[lane])) + wave_max(mb));
    lam = uni(__expf(wave_sum(lq1[lane] * lk1[lane])) - __expf(wave_sum(lq2[lane] * lk2[lane])) + lambda_init); }
    const float c1 = 0.125f * LOG2E, oml = uni(1.f - lambda_init);
    for (int it = 0;; ++it) {
        const int u = it * F.G + F.vcu; if (u >= BATCH * 8 * 16) break;
        const int b = u >> 7, h = (u >> 4) & 7, qb = u & 15;
        const int lane = fresh_lane(), r32 = lane & 31, hi = lane >> 5, tid = w * 64 + lane;
        LAS char* const Qs = L0 + 81920 + w * 8192 + lane * 16;
        const unsigned kvo = (unsigned)lane * 6144u + (unsigned)w * 16u;
        const unsigned vvo = (unsigned)(16 * (w & 3) + (lane >> 2)) * 6144u + (unsigned)(w >> 2) * 64u + (unsigned)(lane & 3) * 16u;
        const unsigned kdst = lds0 + w * 1024, vdst = lds0 + 32768 + w * 1024;
        const size_t tokb = (size_t)b * SEQ; const int qw0 = qb * 256 + 32 * w, q = qw0 + r32;
        ATT_WAIT_BAR();
        TBL[tid] = (rel_bias[t5_bucket(tid - 256) * 8 + h] - shift) * LOG2E;
        const float cbp = uni((rel_bias[31 * 8 + h] - shift) * LOG2E), cbn = uni((rel_bias[15 * 8 + h] - shift) * LOG2E);
        gcb_t kbase = QKV + tokb * 3072 + 1024 + h * 128;
        gcb_t vbase = QKV + tokb * 3072 + 2048 + h * 128;
#define DIFF_DMA(t, ks_, vs_) do { gcb_t kb_ = kbase + (size_t)(t) * 64 * 3072; gcb_t vb_ = vbase + (size_t)(t) * 64 * 3072; \
            glds16s(kb_, kvo, (unsigned)__builtin_amdgcn_readfirstlane(kdst + (ks_))); glds16s(kb_ + 64, kvo, (unsigned)__builtin_amdgcn_readfirstlane(kdst + (ks_) + 8192)); \
            glds16s(vb_, vvo, (unsigned)__builtin_amdgcn_readfirstlane(vdst + (vs_))); glds16s(vb_ + 64, vvo, (unsigned)__builtin_amdgcn_readfirstlane(vdst + (vs_) + 8192)); } while (0)
#define DIFF_DMA_K(t, ks_) do { kptr += 64 * 3072; const unsigned d_ = (unsigned)__builtin_amdgcn_readfirstlane(kdst + (ks_)); glds16s_pair(kptr, kvo, d_, d_ + (8192u - 128u)); } while (0)
#define DIFF_DMA_V(t, vs_) do { vptr += 64 * 3072; const unsigned d_ = (unsigned)__builtin_amdgcn_readfirstlane(vdst + (vs_)); glds16s_pair(vptr, vvo, d_, d_ + (8192u - 128u)); } while (0)
        gcb_t kptr = kbase, vptr = vbase;
        DIFF_DMA(0, 0, 0);
        { gcb_t qp = QKV + (tokb + q) * 3072 + h * 128 + hi * 8;
#pragma unroll
          for (int cc = 0; cc < 2; ++cc)
#pragma unroll
              for (int d0 = 0; d0 < 4; ++d0) *(LAS bf16x8*)(Qs + (cc * 4 + d0) * 1024) = *(const GAS bf16x8*)(qp + cc * 64 + d0 * 16); }
        float l0 = 0.f, l1 = 0.f; f32x16 oa[4] = {}, ob[4] = {};
        const int vlane = (4 * hi + ((lane & 15) >> 2)) * 64 + ((lane >> 4) & 1) * 32 + (lane & 3) * 8;
        int vs_cur = 0, vs_prev = 0;
#define SB_ __builtin_amdgcn_sched_barrier(0)
#define LDK(c, d0, hf) (*(const LAS bf16x8*)(Kb + (c) * 8192 + (d0) * 2048 + (hf) * 512))
#define LDQ(c, d0) (*(const LAS bf16x8*)(Qs + ((c) * 4 + (d0)) * 1024))
#define LDV(VB, j, db, ks) do { vlo[j] = vtr((VB) + (db) * 4096 + (ks) * 1024); vhi[j] = vtr((VB) + (db) * 4096 + (ks) * 1024 + 512); } while (0)
#define EL_B(LS, e, B) do { const float p_ = __builtin_amdgcn_exp2f(sc[e] * c1 + (B)); sc[e] = p_; LS += p_; } while (0)
#define NEAR_B(R, e, KOFF) (TBL[(R) + ((KOFF) + ((e) & 3) + 8 * ((e) >> 2))])
#define MIXSTEP(VB, KS0, i, OACC, LS, NEAR, KOFF, PF, NC, NHF) do { if ((i) + 2 < 8) LDV(VB, (i) + 2, ((i) + 2) >> 1, (KS0) + (((i) + 2) & 1)); \
            if (PF) { if ((i) < 4) ka[i] = LDK(NC, i, NHF); else if ((PF) == 2) qa[(i) - 4] = LDQ(NC, (i) - 4); } \
            { const bf16x8 vf = __builtin_shufflevector(vlo[i], vhi[i], 0, 1, 2, 3, 4, 5, 6, 7); OACC[(i) >> 1] = MFMA32(((i) & 1) ? pp1 : pp0, vf, OACC[(i) >> 1]); } \
            { float x0_ = sc[2 * (i)], x1_ = sc[2 * (i) + 1]; \
              if (NEAR) { const int l_ = fresh_lane(); const int r_ = 4 * (l_ >> 5) - (l_ & 31) + (rbt - qw0); \
                  x0_ += NEAR_B(r_, 2 * (i), KOFF); x1_ += NEAR_B(r_, 2 * (i) + 1, KOFF); } \
              asm volatile("v_exp_f32 %0, %0\n\tv_exp_f32 %1, %1\n\tv_add_f32 %2, %2, %0\n\tv_add_f32 %2, %2, %1" : "+v"(x0_), "+v"(x1_), "+v"(LS)); \
              sc[2 * (i)] = x0_; sc[2 * (i) + 1] = x1_; } \
            SB_; } while (0)
#define HALFROUND(NEAR, HF, VB, KS0, OPREV, LS, PF, NC, NHF) do { \
            f32x16 sc = {}; \
            LDV(VB, 0, 0, (KS0)); LDV(VB, 1, 0, (KS0) + 1); \
            _Pragma("unroll") for (int d0 = 0; d0 < 4; ++d0) sc = MFMA32(ka[d0], qa[d0], sc); \
            SB_; \
            MIXSTEP(VB, KS0, 0, OPREV, LS, NEAR, 32 * (HF), PF, NC, NHF); MIXSTEP(VB, KS0, 1, OPREV, LS, NEAR, 32 * (HF), PF, NC, NHF); MIXSTEP(VB, KS0, 2, OPREV, LS, NEAR, 32 * (HF), PF, NC, NHF); MIXSTEP(VB, KS0, 3, OPREV, LS, NEAR, 32 * (HF), PF, NC, NHF); \
            MIXSTEP(VB, KS0, 4, OPREV, LS, NEAR, 32 * (HF), PF, NC, NHF); MIXSTEP(VB, KS0, 5, OPREV, LS, NEAR, 32 * (HF), PF, NC, NHF); MIXSTEP(VB, KS0, 6, OPREV, LS, NEAR, 32 * (HF), PF, NC, NHF); MIXSTEP(VB, KS0, 7, OPREV, LS, NEAR, 32 * (HF), PF, NC, NHF); \
            pp0 = pack8(sc, 0); pp1 = pack8(sc, 1); \
            SB_; } while (0)
#define TILE(NEAR) do { \
            HALFROUND(NEAR, 0, Vp, 2, ob, l0, 1, 0, 1); \
            if (t < 63) DIFF_DMA_K(t + 1, 16384 - kslot); \
            HALFROUND(NEAR, 1, Vb, 0, oa, l0, 2, 1, 0); \
            if (t < 63) DIFF_DMA_V(t + 1, vsn_); \
            HALFROUND(NEAR, 0, Vb, 2, oa, l1, 1, 1, 1); \
            HALFROUND(NEAR, 1, Vb, 0, ob, l1, 0, 0, 0); } while (0)
        bf16x8 pp0 = {}, pp1 = {};
        s16x4 vlo[8], vhi[8];
        int tn0 = (qw0 - 154) >> 6; tn0 = tn0 < -1 ? 0 : tn0 + 1; int tn1 = (qw0 + 122 + 63) >> 6; tn1 = tn1 > 64 ? 64 : tn1;
#define TILE_LOOP(T0, T1, NEAR) for (int t = (T0); t < (T1); ++t) { \
            const int kslot = (t & 1) * 16384; int vsn_ = 0; \
            ATT_WAIT_BAR(); \
            { if (t > 0) { vs_prev = vs_cur; vs_cur = vs_cur + 16384; vs_cur = vs_cur >= 49152 ? 0 : vs_cur; } \
              int vs_next = vs_cur + 16384; vs_next = vs_next >= 49152 ? 0 : vs_next; vsn_ = vs_next; } \
            const LAS char* Kb = L0 + kslot + hi * 1024 + r32 * 16; const LAS char* Vb = L0 + 32768 + vs_cur + vlane; const LAS char* Vp = L0 + 32768 + vs_prev + vlane; \
            const int rbt = 64 * t + 256; \
            bf16x8 ka[4], qa[4]; \
            _Pragma("unroll") for (int d0 = 0; d0 < 4; ++d0) { ka[d0] = LDK(0, d0, 0); qa[d0] = LDQ(0, d0); } \
            SB_; \
            TILE(NEAR); }
#define PV_DRAIN() do { const LAS char* Vd_ = L0 + 32768 + vs_cur + vlane; LDV(Vd_, 0, 0, 2); LDV(Vd_, 1, 0, 3); \
            _Pragma("unroll") for (int i = 0; i < 8; ++i) { if (i + 2 < 8) LDV(Vd_, i + 2, (i + 2) >> 1, 2 + ((i + 2) & 1)); \
                const bf16x8 vf = __builtin_shufflevector(vlo[i], vhi[i], 0, 1, 2, 3, 4, 5, 6, 7); \
                ob[i >> 1] = MFMA32((i & 1) ? pp1 : pp0, vf, ob[i >> 1]); SB_; } \
            pp0 = (bf16x8){}; pp1 = (bf16x8){}; } while (0)
#define OL_SCALE(f) do { const float f_ = (f); l0 *= f_; l1 *= f_; _Pragma("unroll") for (int db = 0; db < 4; ++db) { oa[db] *= f_; ob[db] *= f_; } } while (0)
        TILE_LOOP(0, tn0, false)
        if (tn0 > 0) { PV_DRAIN(); OL_SCALE(__builtin_amdgcn_exp2f(cbn)); }
        TILE_LOOP(tn0, tn1, true)
        PV_DRAIN(); OL_SCALE(__builtin_amdgcn_exp2f(-cbp));
        TILE_LOOP(tn1, 64, false)
        if (tn1 < 64) PV_DRAIN();
#undef OL_SCALE
#undef PV_DRAIN
#undef TILE_LOOP
#undef TILE
#undef HALFROUND
#undef MIXSTEP
#undef NEAR_B
#undef EL_B
#undef LDV
#undef LDQ
#undef LDK
#undef SB_
#undef DIFF_DMA
#undef DIFF_DMA_K
#undef DIFF_DMA_V
        { const int fl_ = fresh_lane() & 63; wsc[fl_] = l0; wsc[64 + fl_] = l1; }
        ATT_WAIT_BAR();
        diff_epilogue(oa, ob, wsc, lam, oml, subg, L0, w, AO, tokb, qw0, h);
    }
    ATT_WAIT_BAR();
}

typedef float f32x4v __attribute__((ext_vector_type(4)));
DI void router_phase(const Frame& F, gcb_t x, gcf_t g, gcf_t wg, gcf_t bg, gcf_t we, gcf_t be, gf_t rs2, TokG T, gu_t cnt) {
    const int lane = F.lane, n16 = lane & 15, kq = lane >> 4, w = F.wave;
    LAS float* const WL = (LAS float*)F.lds;
    LAS float* const scr = (LAS float*)(F.lds + 131072) + w * 512;
    __syncthreads();
    {
        f32x4 cw[2][5]; float gk[2];
#pragma unroll
        for (int rr = 0; rr < 2; ++rr) { const int k = F.tid + rr * NTHREADS; gk[rr] = g[k]; cw[rr][0] = ((const GAS f32x4*)wg)[k];
#pragma unroll
            for (int q = 0; q < 4; ++q) cw[rr][1 + q] = ((const GAS f32x4*)we)[k * 4 + q]; }
        LAS unsigned short* const WH = (LAS unsigned short*)F.lds; LAS unsigned short* const WLo = (LAS unsigned short*)(F.lds + 65536);
#pragma unroll
        for (int rr = 0; rr < 2; ++rr) { const int k = F.tid + rr * NTHREADS, Tt = k >> 5, kq_ = (k >> 3) & 3, j = k & 7;
#pragma unroll
            for (int c = 0; c < 32; ++c) { const int oh = c >> 4, n = c & 15; const int idx = (((Tt * 2 + oh) * 4 + kq_) * 16 + n) * 8 + j;
                unsigned short hb = 0, lb = 0;
                if (c < 20) { const float wv = cw[rr][c >> 2][c & 3] * gk[rr]; hb = (unsigned short)f2bf(wv); lb = (unsigned short)f2bf(wv - bf2f(hb)); }
                WH[idx] = hb; WLo[idx] = lb; } }
    }
    if (F.tid < 16) F.MISC[64 + F.tid] = 0u;
    __syncthreads();
    const LAS char* const Wb = (const LAS char*)F.lds + lane * 16;
    const int gw = F.vcu * NWAVES + F.wave, NGW = F.G * NWAVES;
    float bgv[4], bev[16];
#pragma unroll
    for (int i = 0; i < 4; ++i) bgv[i] = bg[i];
#pragma unroll
    for (int i = 0; i < 16; ++i) bev[i] = be[i];
    asm volatile("" : "+v"(bgv[0]), "+v"(bgv[1]), "+v"(bgv[2]), "+v"(bgv[3]));
    asm volatile("" : "+v"(bev[0]), "+v"(bev[1]), "+v"(bev[2]), "+v"(bev[3]), "+v"(bev[4]), "+v"(bev[5]), "+v"(bev[6]), "+v"(bev[7]));
    asm volatile("" : "+v"(bev[8]), "+v"(bev[9]), "+v"(bev[10]), "+v"(bev[11]), "+v"(bev[12]), "+v"(bev[13]), "+v"(bev[14]), "+v"(bev[15]));
    for (int task = gw; task < M / 16; task += NGW) {
        const int tok0 = task * 16;
        const GAS u32x4* xr = (const GAS u32x4*)(x + (size_t)(tok0 + n16) * D) + kq;
        f32x4v a0 = {0.f, 0.f, 0.f, 0.f}, a1 = {0.f, 0.f, 0.f, 0.f}; float ssq = 0.f;
        u32x4 rr_[32];
#pragma unroll
        for (int Tt = 0; Tt < 32; ++Tt) rr_[Tt] = xr[4 * Tt];
#pragma unroll
        for (int Tt = 0; Tt < 32; ++Tt) {
            const u32x4 r_ = rr_[Tt];
            float xv[8];
#pragma unroll
            for (int e = 0; e < 4; ++e) { xv[2 * e] = bf2f((unsigned short)(r_[e] & 0xffffu)); xv[2 * e + 1] = bf2f((unsigned short)(r_[e] >> 16)); }
#pragma unroll
            for (int e = 0; e < 8; ++e) ssq += xv[e] * xv[e];
            const bf16x8 av = __builtin_bit_cast(bf16x8, r_);
            const bf16x8 bh0 = *(const LAS bf16x8*)(Wb + (Tt * 2) * 1024), bh1 = *(const LAS bf16x8*)(Wb + (Tt * 2 + 1) * 1024);
            const bf16x8 bl0 = *(const LAS bf16x8*)(Wb + 65536 + (Tt * 2) * 1024), bl1 = *(const LAS bf16x8*)(Wb + 65536 + (Tt * 2 + 1) * 1024);
            a0 = __builtin_amdgcn_mfma_f32_16x16x32_bf16(av, bh0, a0, 0, 0, 0); a0 = __builtin_amdgcn_mfma_f32_16x16x32_bf16(av, bl0, a0, 0, 0, 0);
            a1 = __builtin_amdgcn_mfma_f32_16x16x32_bf16(av, bh1, a1, 0, 0, 0); a1 = __builtin_amdgcn_mfma_f32_16x16x32_bf16(av, bl1, a1, 0, 0, 0);
        }
#pragma unroll
        for (int r = 0; r < 4; ++r) { scr[(4 * kq + r) * 32 + n16] = a0[r]; scr[(4 * kq + r) * 32 + 16 + n16] = a1[r]; }
        asm volatile("s_waitcnt lgkmcnt(0)" ::: "memory");
        scr[n16 * 32 + 20 + kq] = ssq;
        asm volatile("s_waitcnt lgkmcnt(0)" ::: "memory");
        float rstd = 0.f;
        if (lane < 16) {
            float lg[24];
#pragma unroll
            for (int q4 = 0; q4 < 6; ++q4) { const f32x4v t4 = *(const LAS f32x4v*)(scr + lane * 32 + 4 * q4); lg[4 * q4] = t4[0]; lg[4 * q4 + 1] = t4[1]; lg[4 * q4 + 2] = t4[2]; lg[4 * q4 + 3] = t4[3]; }
            rstd = rsqrtf(((lg[20] + lg[21]) + (lg[22] + lg[23])) * (1.f / D) + RMS_EPS);
            const int tok = tok0 + lane;
            rs2[tok] = rstd;
            float gl[4]; int gi = 0; float gm = -1e30f;
#pragma unroll
            for (int i = 0; i < 4; ++i) { gl[i] = lg[i] * rstd + bgv[i]; if (gl[i] > gm) { gm = gl[i]; gi = i; } }
            float gs = 0.f;
#pragma unroll
            for (int i = 0; i < 4; ++i) gs += __expf(gl[i] - gm);
            const float gp = 1.f / gs;
            float el[4];
#pragma unroll
            for (int i = 0; i < 4; ++i) { float t = 0.f;
#pragma unroll
                for (int gq = 0; gq < 4; ++gq) t = (gq == gi) ? (lg[4 + gq * 4 + i] * rstd + bev[gq * 4 + i]) : t;
                el[i] = t; }
            int i0 = 0; float m0 = el[0];
#pragma unroll
            for (int i = 1; i < 4; ++i) if (el[i] > m0) { m0 = el[i]; i0 = i; }
            int i1 = -1; float m1 = -1e30f;
#pragma unroll
            for (int i = 0; i < 4; ++i) if (i != i0 && el[i] > m1) { m1 = el[i]; i1 = i; }
            const float e1 = __expf(m1 - m0), w0 = gp / (1.f + e1), w1 = gp * e1 / (1.f + e1);
            const int E0 = gi * 4 + i0, E1 = gi * 4 + i1;
            T.tok_e[tok * 2] = E0; T.tok_e[tok * 2 + 1] = E1; T.tok_w[tok * 2] = w0; T.tok_w[tok * 2 + 1] = w1;
            __hip_atomic_fetch_add((LAS unsigned*)&F.MISC[64 + E0], 1u, __ATOMIC_RELAXED, __HIP_MEMORY_SCOPE_WORKGROUP); __hip_atomic_fetch_add((LAS unsigned*)&F.MISC[64 + E1], 1u, __ATOMIC_RELAXED, __HIP_MEMORY_SCOPE_WORKGROUP);
        }
    }
    __syncthreads();
    { const int t2 = F.wave * 64 + fresh_lane(); if (t2 < 16) { const unsigned c = F.MISC[64 + t2]; if (c) atomicAdd((unsigned*)&cnt[t2], c); } }
}
DI void assign_phase(const Frame& F, gcu_t cnt, gu_t cur, TokG T, gi_t tile_e, gcf_t rs2, gf_t srs) {
    const int lane = F.lane;
    int pst = 0, myc = 0;
    { int acc = 0;
#pragma unroll
      for (int e = 0; e < NE; ++e) { const int c = (int)cnt[e]; if (lane == e) { pst = acc; myc = c; } acc += (c + 255) / 256 * 256; } }
    const unsigned long long ltmask = (1ull << lane) - 1ull;
    if (F.wave < 2) {
        for (int tok = (F.bx * 2 + F.wave) * 64 + lane; tok < M; tok += F.G * 128) {
            const int e0 = T.tok_e[tok * 2], e1 = T.tok_e[tok * 2 + 1]; int r0 = 0, r1 = 0, tot = 0;
#pragma unroll
            for (int ee = 0; ee < NE; ++ee) {
                const unsigned long long m0 = __ballot(e0 == ee), m1 = __ballot(e1 == ee);
                const int n0 = __popcll(m0), n1 = __popcll(m1);
                if (e0 == ee) r0 = __popcll(m0 & ltmask);
                if (e1 == ee) r1 = n0 + __popcll(m1 & ltmask);
                if (lane == ee) tot = n0 + n1;
            }
            int base = pst;
            if (lane < NE && tot > 0) base += (int)atomicAdd((unsigned*)&cur[lane], (unsigned)tot);
            const int s0 = __shfl(base, e0) + r0, s1 = __shfl(base, e1) + r1;
            T.slot_tok[s0] = tok; T.slot_tok[s1] = tok; T.tok_slot[tok * 2] = s0; T.tok_slot[tok * 2 + 1] = s1;
            { const float rv = rs2[tok]; srs[s0] = rv; srs[s1] = rv; }
        }
    }
    if (F.bx == F.G - 1 && F.wave >= 2) {
        for (int e = 0; e < NE; ++e) { const int ps = __shfl(pst, e), pc = __shfl(myc, e); const int padded = (pc + 255) / 256 * 256;
            for (int j2 = pc + (F.tid - 128); j2 < padded; j2 += NTHREADS - 128) { T.slot_tok[ps + j2] = 0; srs[ps + j2] = 0.f; }
            for (int tI = ps / 256 + (F.tid - 128); tI < (ps + padded) / 256; tI += NTHREADS - 128) tile_e[tI] = e; }
        { const int pe = __shfl(pst, NE - 1), ce = __shfl(myc, NE - 1); for (int tI = (pe + (ce + 255) / 256 * 256) / 256 + (F.tid - 128); tI < MAXT + 1; tI += NTHREADS - 128) tile_e[tI] = -1; }
    }
}
DI int moe_setup(const Frame& F, gcu_t cnt, gci_t slot_tok, bool gather) {
    __syncthreads();
    if (F.tid < 64) {
        const int ln = F.tid; int v = ln < NE ? ((int)cnt[ln & (NE - 1)] + 255) / 256 : 0;
#pragma unroll
        for (int d = 1; d < NE; d <<= 1) { const int t = __shfl_up(v, d); if (ln >= d) v += t; }
        if (ln < NE) F.MISC[16 + ln] = (unsigned)v;
        if (ln == NE - 1) F.MISC[32] = (unsigned)v; }
    __syncthreads();
    const int ntiles = (int)F.MISC[32];
    if (gather) { LAS int* rows = (LAS int*)(F.lds + ROWS_OFF);
        int rv[6];
#pragma unroll
        for (int i = 0; i < 6; ++i) { const int L = i * F.G + F.vcu; const int rt = L >> 2; rv[i] = (L < ntiles * 4 && F.tid < 256) ? slot_tok[rt * 256 + F.tid] : 0; }
        asm volatile("" : "+v"(rv[0]), "+v"(rv[1]), "+v"(rv[2]), "+v"(rv[3]), "+v"(rv[4]), "+v"(rv[5]));
#pragma unroll
        for (int i = 0; i < 6; ++i) { const int L = i * F.G + F.vcu; if (L < ntiles * 4 && F.tid < 256) rows[i * 256 + F.tid] = rv[i]; }
        __syncthreads(); }
    return ntiles;
}
DI void combine_phase(const Frame& F, gb_t x, gf_t out32, gcb_t Y, TokG T, gf_t rs1) {
    const int lane = F.lane, gw = F.vcu * NWAVES + F.wave, NGW = F.G * NWAVES;
    static_assert(M % (NWAVES * 256) == 0, "tokens per wave");
    const int ntk = M / NGW;
    int sl0 = 0, sl1 = 0; float ww0 = 0.f, ww1 = 0.f;
    if (lane < ntk) { const int tk = gw + NGW * lane; sl0 = T.tok_slot[tk * 2]; sl1 = T.tok_slot[tk * 2 + 1]; ww0 = T.tok_w[tk * 2]; ww1 = T.tok_w[tk * 2 + 1]; }
    for (int i0 = 0; i0 < ntk; i0 += 4) {
        u32x4 xa[4][2], ya[4][2], yb[4][2];
#pragma unroll
        for (int tt = 0; tt < 4; ++tt) { const int i = i0 + tt, tok = gw + NGW * i;
            const int s0 = __builtin_amdgcn_readlane(sl0, i), s1 = __builtin_amdgcn_readlane(sl1, i);
            const GAS u32x4* xr = (const GAS u32x4*)(x + (size_t)tok * D) + lane * 2;
            const GAS u32x4* y0 = (const GAS u32x4*)(Y + (size_t)s0 * D) + lane * 2; const GAS u32x4* y1 = (const GAS u32x4*)(Y + (size_t)s1 * D) + lane * 2;
            xa[tt][0] = xr[0]; xa[tt][1] = xr[1]; ya[tt][0] = y0[0]; ya[tt][1] = y0[1]; yb[tt][0] = y1[0]; yb[tt][1] = y1[1]; }
#pragma unroll
        for (int tt = 0; tt < 4; ++tt) { const int i = i0 + tt, tok = gw + NGW * i;
            const float w0 = __builtin_bit_cast(float, __builtin_amdgcn_readlane(__builtin_bit_cast(int, ww0), i)), w1 = __builtin_bit_cast(float, __builtin_amdgcn_readlane(__builtin_bit_cast(int, ww1), i));
            float s = 0.f;
#pragma unroll
            for (int hh = 0; hh < 2; ++hh) { float v[8];
#pragma unroll
                for (int e = 0; e < 4; ++e) { const unsigned c = xa[tt][hh][e], a = ya[tt][hh][e], b = yb[tt][hh][e];
                    v[2 * e] = bf2f(c & 0xffff) + w0 * bf2f(a & 0xffff) + w1 * bf2f(b & 0xffff); v[2 * e + 1] = bf2f(c >> 16) + w0 * bf2f(a >> 16) + w1 * bf2f(b >> 16);
                    s += v[2 * e] * v[2 * e] + v[2 * e + 1] * v[2 * e + 1]; }
                if (out32) { GAS f32x4* op = (GAS f32x4*)(out32 + (size_t)tok * D) + lane * 4 + hh * 2; op[0] = (f32x4){v[0], v[1], v[2], v[3]}; op[1] = (f32x4){v[4], v[5], v[6], v[7]}; }
                else { u32x4 wv; wv.x = cvtpk(v[0], v[1]); wv.y = cvtpk(v[2], v[3]); wv.z = cvtpk(v[4], v[5]); wv.w = cvtpk(v[6], v[7]); ((GAS u32x4*)(x + (size_t)tok * D) + lane * 2)[hh] = wv; } }
            if (!out32) { const float r = rsqrtf(wave_sum(s) * (1.f / D) + RMS_EPS); if (lane == 0) rs1[tok] = r; } }
    }
}

constexpr int NPHASE = 1 + 8 * DEPTH;
#ifndef PHMASK
#define PHMASK 0x3ff
#endif
#define EN(k) (((PHMASK) >> (k)) & 1)
#ifndef REPMASK
#define REPMASK 0
#endif
#define NREP(k) (1 + (((REPMASK) >> (k)) & 1))
__global__ void __launch_bounds__(NTHREADS, 2) mega(Args a) {
    extern __shared__ __attribute__((aligned(16))) unsigned char lds_raw[];
    Frame F;
    F.lds = (LAS unsigned char*)lds_raw; F.MISC = (volatile LAS unsigned*)(F.lds + MISC_OFF);
    F.tid = threadIdx.x; F.lane = F.tid & 63; F.wave = __builtin_amdgcn_readfirstlane(F.tid >> 6);
    F.G = gridDim.x; F.bx = blockIdx.x; { const int bx = blockIdx.x; F.vcu = (F.G % 8 == 0) ? (bx % 8) * (F.G / 8) + bx / 8 : bx; }
    F.ws = (guc_t)a.ws; F.ctl = (gu_t)(F.ws + WS_CTL);
    for (int u = F.tid; u < 256; u += NTHREADS) F.MISC[u] = 0u;
    __syncthreads();
    const int lo = a.ph_lo, hi = a.ph_hi;
    if (lo >= 100) { Frame FC = F; FC.lane = fresh_lane(); FC.tid = F.wave * 64 + FC.lane; convert_layer(FC, a, lo - 100); return; }
    XcdBarrier bar = xcd_barrier_post((unsigned*)(F.ctl + CW_BAR + lo * XCD_BAR_WORDS), F.MISC + 8, F.wave);
#define IN(k) (lo <= (k) && (k) < hi)
#define SEAM(k) do { if (IN(k) && IN((k) + 1)) xcd_barrier(bar); } while (0)
#define INP(i) ((gcf_t)al.in[i])
#define FRESH(FP) Frame FP = FL; FP.lane = fresh_lane(); FP.tid = FL.wave * 64 + FP.lane

    if (EN(0) && IN(0)) {
        Frame FC = F; FC.lane = fresh_lane(); FC.tid = F.wave * 64 + FC.lane;
        convert_layer(FC, a, 0);
        const int gw = F.vcu * NWAVES + F.wave, NGW = F.G * NWAVES;
        gb_t X0 = (gb_t)(F.ws + WS_X16); gcf_t x0 = (gcf_t)a.in[0]; gf_t rs0 = (gf_t)(F.ws + WS_TOK + 1536 * 1024);
        {
            f32x4 ra[4], rb[4]; int m = gw;
            if (m < M) stream_load(x0 + (size_t)m * D, ra, FC.lane);
            for (; m < M; m += 2 * NGW) {
                const bool hb = m + NGW < M;
                if (hb) stream_load(x0 + (size_t)(m + NGW) * D, rb, FC.lane);
                stream_store(ra, X0 + (size_t)m * D, rs0 + m, FC.lane);
                if (!hb) break;
                const bool ha = m + 2 * NGW < M;
                if (ha) stream_load(x0 + (size_t)(m + 2 * NGW) * D, ra, FC.lane);
                stream_store(rb, X0 + (size_t)(m + NGW) * D, rs0 + m + NGW, FC.lane);
                if (!ha) break;
            }
        }
    }
    SEAM(0);
    for (int L = 0; L < DEPTH; ++L) {
        const int pb = 1 + 8 * L, j = L >> 1; const bool is_na = !(L & 1);
        Frame FL = F; int bxL = (int)blockIdx.x; asm volatile("" : "+s"(FL.vcu), "+s"(FL.G), "+s"(bxL)); FL.bx = bxL;
        guc_t wsL = F.ws; gf_t out = (gf_t)a.out; asm volatile("" : "+s"(wsL), "+s"(out));
        Args al = a;
#pragma unroll
        for (int i = 0; i < 25; ++i) asm volatile("" : "+s"(al.in[i]));
        gb_t Wqkvp = (gb_t)(wsL + WS_WQKVP); gb_t Wo_t = (gb_t)(wsL + WS_WO); gb_t Wgu_t = (gb_t)(wsL + WS_WGU); gb_t Wd_t = (gb_t)(wsL + WS_WD);
        gf_t RS1 = (gf_t)(wsL + WS_TOK + 1536 * 1024), RS2 = (gf_t)(wsL + WS_TOK + 1792 * 1024), SRS = (gf_t)(wsL + WS_TOK + 2048 * 1024);
        gb_t QKV = (gb_t)(wsL + WS_QKV); gb_t AO = (gb_t)(wsL + WS_AO); gb_t Hb = (gb_t)(wsL + WS_H); gb_t Yb = (gb_t)(wsL + WS_Y);
        TokG T; T.tok_e = (gi_t)(wsL + WS_TOK); T.tok_w = (gf_t)(wsL + WS_TOK + 256 * 1024); T.tok_slot = (gi_t)(wsL + WS_TOK + 512 * 1024); T.slot_tok = (gi_t)(wsL + WS_TOK + 768 * 1024);
        gi_t tile_e = (gi_t)(wsL + WS_TOK + 768 * 1024 + 512 * 1024); gb_t X16 = (gb_t)(wsL + WS_X16);
        if (EN(1) && IN(pb)) for (int rep_ = 0; rep_ < NREP(1); ++rep_) { FRESH(FP);
            pg8::DenseOrder S; S.init(M, 3072, 1024, FL.G, bxL, (gcc_t)X16, (gcc_t)Wqkvp);
            pg8::EpiQKV E{QKV, (is_na ? INP(5) : INP(10)) + j * 64, (is_na ? INP(6) : INP(11)) + j * 64, (gcf_t)RS1, is_na ? 1.f : 0.125f * LOG2E};
            pg8::gemm_phase<pg8::EpiQKV, pg8::DenseOrder, false>(FP.tid, FP.lds, 1024, S, E, nullptr);
        }
        SEAM(pb);
        if (IN(pb + 1)) {
            if (!EN(3) || (EN(2) && is_na)) { if (EN(2)) for (int rep_ = 0; rep_ < NREP(2); ++rep_) { FRESH(FP); na_phase(FP, QKV, INP(7) + (size_t)j * 16 * 465, INP(5) + j * 64, INP(6) + j * 64, AO); } }
            else for (int rep_ = 0; rep_ < NREP(3); ++rep_) { FRESH(FP); diff_phase(FP, QKV, INP(17), INP(10) + j * 64, INP(11) + j * 64, INP(12) + j * 64, INP(13) + j * 64, INP(14) + j * 64, INP(15) + j * 64, INP(16) + j * 128,
                            0.8f - 0.6f * __expf(-0.3f * (float)L), AO); }
        }
        SEAM(pb + 1);
        if (EN(4) && IN(pb + 2)) { FRESH(FP);
            pg8::DenseOrder S; S.init(M, 1024, 1024, FL.G, bxL, (gcc_t)AO, (gcc_t)Wo_t);
            pg8::EpiRes<true> E{INP(0), (gcb_t)X16, X16}; pg8::gemm_phase<pg8::EpiRes<true>, pg8::DenseOrder, false>(FP.tid, FP.lds, 1024, S, E, nullptr);
        }
        SEAM(pb + 2);
        gu_t cnt = (gu_t)(wsL + WS_CTL) + CW_CNT + L * 16; gu_t cur = (gu_t)(wsL + WS_CTL) + CW_CUR + L * 16;
        if (EN(5) && IN(pb + 3)) { FRESH(FP); router_phase(FP, (gcb_t)X16, INP(2) + L * 1024, INP(18) + (size_t)L * 1024 * 4, INP(19) + L * 4, INP(20) + (size_t)L * 1024 * 16, INP(21) + L * 16, RS2, T, cnt); }
        SEAM(pb + 3);
        if (EN(6) && IN(pb + 4)) { FRESH(FP); assign_phase(FP, cnt, cur, T, tile_e, (gcf_t)RS2, SRS); }
        SEAM(pb + 4);
        if (EN(7) && IN(pb + 5)) for (int rep_ = 0; rep_ < NREP(7); ++rep_) { FRESH(FP);
            const int ntiles = moe_setup(FP, cnt, T.slot_tok, true);
            pg8::MoeOrder S{ntiles * 4, FL.G, FL.vcu, 1024, (gcc_t)X16, (gcc_t)Wgu_t, (size_t)1024 * 1024 * 2, (const LAS int*)(FP.lds + MISC_OFF + 64), true};
            pg8::EpiGateUp E{Hb, (gcf_t)SRS};
            pg8::gemm_phase<pg8::EpiGateUp, pg8::MoeOrder, true>(FP.tid, FP.lds, 1024, S, E, (const LAS int*)(FP.lds + ROWS_OFF));
        }
        SEAM(pb + 5);
        if (EN(8) && IN(pb + 6)) for (int rep_ = 0; rep_ < NREP(8); ++rep_) { FRESH(FP);
            const int ntiles = moe_setup(FP, cnt, T.slot_tok, false);
            pg8::MoeOrder S{ntiles * 4, FL.G, FL.vcu, 512, (gcc_t)Hb, (gcc_t)Wd_t, (size_t)1024 * 512 * 2, (const LAS int*)(FP.lds + MISC_OFF + 64), false};
            pg8::EpiBf16 E{Yb, 1024};
            pg8::gemm_phase<pg8::EpiBf16, pg8::MoeOrder, false>(FP.tid, FP.lds, 512, S, E, nullptr);
        }
        SEAM(pb + 6);
        if (EN(9) && IN(pb + 7)) { FRESH(FP);
            if (L + 1 < DEPTH) convert_layer(FP, al, L + 1);
            combine_phase(FP, X16, L + 1 < DEPTH ? (gf_t)nullptr : out, Yb, T, RS1);
        }
        SEAM(pb + 7);
    }
#undef IN
#undef SEAM
#undef INP
#undef FRESH
}


#ifndef MK_MODE
#define MK_MODE 1
#endif
#ifndef NEWMASK
#define NEWMASK 0x3ff
#endif
extern "C" void kernel_launch(void* const* d_in, const int* in_sizes, int n_in, void* d_out, int out_size, void* d_ws, size_t ws_size, hipStream_t stream) {
    if (n_in != 25 || ws_size < WS_END2) { fprintf(stderr, "kernel_launch: unexpected n_in %d / ws %zu\n", n_in, ws_size); return; }
    static int grid = 0;
    if (grid == 0) {
        int dev = 0, cus = 0;
        if (hipGetDevice(&dev) != hipSuccess || hipDeviceGetAttribute(&cus, hipDeviceAttributeMultiprocessorCount, dev) != hipSuccess) { grid = -1; return; }
        if (hipFuncSetAttribute((const void*)mega, hipFuncAttributeMaxDynamicSharedMemorySize, LDS_BYTES) != hipSuccess) { grid = -1; return; }
        int per_cu = 0;
        if (hipOccupancyMaxActiveBlocksPerMultiprocessor(&per_cu, (const void*)mega, NTHREADS, LDS_BYTES) != hipSuccess || per_cu < 1) { fprintf(stderr, "kernel_launch: occupancy query says %d\n", per_cu); }
        (void)hipGetLastError();
        grid = cus;
    }
    if (grid < 0) return;
    const float* x = (const float*)d_in[0];
    const float* mix_g = (const float*)d_in[1]; const float* ffn_g = (const float*)d_in[2];
    const float* na_wqkv = (const float*)d_in[3]; const float* na_wo = (const float*)d_in[4]; const float* na_qg = (const float*)d_in[5]; const float* na_kg = (const float*)d_in[6]; const float* na_rpb = (const float*)d_in[7];
    const float* df_wqkv = (const float*)d_in[8]; const float* df_wo = (const float*)d_in[9]; const float* df_qg = (const float*)d_in[10]; const float* df_kg = (const float*)d_in[11];
    const float* lq1 = (const float*)d_in[12]; const float* lk1 = (const float*)d_in[13]; const float* lq2 = (const float*)d_in[14]; const float* lk2 = (const float*)d_in[15];
    const float* subg = (const float*)d_in[16]; const float* rel_bias = (const float*)d_in[17];
    const float* rgw = (const float*)d_in[18]; const float* rgb = (const float*)d_in[19]; const float* rew = (const float*)d_in[20]; const float* reb = (const float*)d_in[21];
    float* out = (float*)d_out; unsigned char* ws = (unsigned char*)d_ws;
    unsigned* ctl = (unsigned*)(ws + WS_CTL);
    bf16_t* Wqkv_t = (bf16_t*)(ws + WS_WQKV); bf16_t* Wo_t = (bf16_t*)(ws + WS_WO); bf16_t* Wgu_t = (bf16_t*)(ws + WS_WGU); bf16_t* Wd_t = (bf16_t*)(ws + WS_WD);
    bf16_t* XN = (bf16_t*)(ws + WS_XN); bf16_t* QKV = (bf16_t*)(ws + WS_QKV); bf16_t* AO = (bf16_t*)(ws + WS_AO); bf16_t* Hb = (bf16_t*)(ws + WS_H); bf16_t* Yb = (bf16_t*)(ws + WS_Y);
    TokArrays T; T.tok_e = (int*)(ws + WS_TOK); T.tok_w = (float*)(ws + WS_TOK + 256 * 1024); T.tok_slot = (int*)(ws + WS_TOK + 512 * 1024); T.slot_tok = (int*)(ws + WS_TOK + 768 * 1024);
    int* tile_e = (int*)(ws + WS_TOK + 768 * 1024 + 512 * 1024);
    float* tbl = (float*)(ws + WS_TBL); float* lamp = (float*)(ws + WS_TBL + 512 * 1024);
    const int BIG = 1 << 30;

    (void)hipMemsetAsync(ws + WS_CTL, 0, 1 * MiB, stream);
    Args a{};
    for (int i = 0; i < 25; ++i) a.in[i] = (const float*)d_in[i];
    a.out = out; a.ws = ws;
#ifndef HOSTREP
#define HOSTREP 0
#endif
#define LAUNCH_MEGA(lo_, hi_) do { a.ph_lo = (lo_); a.ph_hi = (hi_); hipLaunchKernelGGL(mega, dim3(grid), dim3(NTHREADS), LDS_BYTES, stream, a); } while (0)
    if (MK_MODE == 1) { LAUNCH_MEGA(0, NPHASE); return; }
    const unsigned nm = NEWMASK;
    for (int L = 0; L < DEPTH; ++L) {
        const int j = L / 2, pb = 1 + 8 * L; const bool is_na = (L % 2 == 0);
        const float* wqkv = (is_na ? na_wqkv : df_wqkv) + (size_t)j * 1024 * 3072;
        if (nm != 0x3ffu) {
            LAUNCH_MEGA(100 + L, 101 + L);
            k_transpose<<<dim3(3072 / 32, 1024 / 32, 1), 256, 0, stream>>>(wqkv, Wqkv_t, 1024, 3072, BIG, 0, 0, 0, 0, 0);
        }
        if (L == 0) { if (nm & 1u) { LAUNCH_MEGA(0, 1); if (HOSTREP & 1) LAUNCH_MEGA(0, 1); } else k_rmsnorm<<<M / 4, 256, 0, stream>>>(x, mix_g, XN); }
        if (nm & 2u) { LAUNCH_MEGA(pb, pb + 1); if (HOSTREP & 2) LAUNCH_MEGA(pb, pb + 1); }
        else { k_gemm<EpiStoreBf16><<<dim3(3072 / 128, M / 128), 256, 0, stream>>>(XN, Wqkv_t, 1024, 1024, 1024, 0, EpiStoreBf16{QKV, 3072, 0});
               k_qknorm<<<M / 4, 256, 0, stream>>>(QKV, (is_na ? na_qg : df_qg) + j * 64, (is_na ? na_kg : df_kg) + j * 64); }
        if (is_na) { if (nm & 4u) { LAUNCH_MEGA(pb + 1, pb + 2); if (HOSTREP & 4) LAUNCH_MEGA(pb + 1, pb + 2); } else k_na_attn<<<M / 4, 256, 0, stream>>>(QKV, na_rpb + (size_t)j * 16 * 15 * 31, AO); }
        else { if (nm & 8u) { LAUNCH_MEGA(pb + 1, pb + 2); if (HOSTREP & 8) LAUNCH_MEGA(pb + 1, pb + 2); }
               else { const float li = 0.8f - 0.6f * expf(-0.3f * (float)L);
                      k_t5table<<<(8191 * 8 + 255) / 256, 256, 0, stream>>>(rel_bias, tbl, lq1 + j * 64, lk1 + j * 64, lq2 + j * 64, lk2 + j * 64, lamp, li, 0.f);
                      k_diff_attn<<<M / 8, 512, 0, stream>>>(QKV, tbl, lamp, subg + j * 128, AO, 1.f - li, 0.f); } }
        if (nm & 16u) { LAUNCH_MEGA(pb + 2, pb + 3); if ((HOSTREP & 16) && L == 0) for (int r_ = 0; r_ < 4; ++r_) LAUNCH_MEGA(pb + 2, pb + 3); }
        else k_gemm<EpiResidual><<<dim3(1024 / 128, M / 128), 256, 0, stream>>>(AO, Wo_t, 1024, 1024, 1024, 0, EpiResidual{L == 0 ? x : out, out, 1024, 0});
        unsigned* cnt = ctl + CW_CNT + L * 16; unsigned* cur = ctl + CW_CUR + L * 16;
        if (nm & 32u) { LAUNCH_MEGA(pb + 3, pb + 4); if (HOSTREP & 32) { (void)hipMemsetAsync(cnt, 0, 64, stream); LAUNCH_MEGA(pb + 3, pb + 4); } }
        else k_norm_router<<<M / 4, 256, 0, stream>>>(out, ffn_g + L * 1024, rgw + (size_t)L * 1024 * 4, rgb + L * 4, rew + (size_t)L * 1024 * 16, reb + L * 16, XN, T, cnt);
        if (nm & 64u) { LAUNCH_MEGA(pb + 4, pb + 5); if (HOSTREP & 64) { (void)hipMemsetAsync(cur, 0, 64, stream); LAUNCH_MEGA(pb + 4, pb + 5); } } else k_assign<<<M / 256, 256, 0, stream>>>(cnt, cur, T, tile_e);
        if (nm & 128u) { LAUNCH_MEGA(pb + 5, pb + 6); if (HOSTREP & 128) LAUNCH_MEGA(pb + 5, pb + 6); } else k_moe_gateup<<<dim3(512 / 64, CAP / 128), 256, 0, stream>>>(XN, Wgu_t, T.slot_tok, tile_e, Hb);
        if (nm & 256u) { LAUNCH_MEGA(pb + 6, pb + 7); if (HOSTREP & 256) LAUNCH_MEGA(pb + 6, pb + 7); } else k_moe_down<<<dim3(1024 / 128, CAP / 128), 256, 0, stream>>>(Hb, Wd_t, tile_e, Yb);
        if (nm & 512u) LAUNCH_MEGA(pb + 7, pb + 8); else k_combine<<<M / 4, 256, 0, stream>>>(out, Yb, T, L + 1 < DEPTH ? mix_g + (L + 1) * 1024 : nullptr, XN);
    }
}
```

```cpp
#include <hip/hip_runtime.h>
#include <stdint.h>
#include <cstdio>

typedef unsigned short bf16_t;
typedef short bf16x8 __attribute__((ext_vector_type(8)));
typedef float f32x4 __attribute__((ext_vector_type(4)));
typedef unsigned u32x4 __attribute__((ext_vector_type(4)));
typedef unsigned u32x2 __attribute__((ext_vector_type(2)));

constexpr int BATCH = 8, SEQ = 4096, D = 1024, M = BATCH * SEQ, DEPTH = 4;
constexpr int NE = 16, DE = 512, NGRP = 4;
constexpr int CAP = (2 * M / 256 + NE) * 256;
constexpr int MAXT = CAP / 256;
constexpr float RMS_EPS = 1e-6f;

constexpr size_t MiB = 1u << 20;
constexpr size_t WS_CTL = 0;
constexpr size_t WS_WQKV = 1 * MiB;
constexpr size_t WS_WO = 7 * MiB;
constexpr size_t WS_WGU = 9 * MiB;
constexpr size_t WS_WD = 41 * MiB;
constexpr size_t WS_XN = 57 * MiB;
constexpr size_t WS_QKV = 121 * MiB;
constexpr size_t WS_AO = 313 * MiB;
constexpr size_t WS_H = WS_QKV;
constexpr size_t WS_Y = WS_QKV + 68 * MiB;
constexpr size_t WS_TOK = 377 * MiB;
constexpr size_t WS_TBL = 380 * MiB;
constexpr size_t WS_END = 384 * MiB;
constexpr int CW_CNT = 1024;
constexpr int CW_CUR = 2048;

struct TokArrays { int* tok_e; float* tok_w; int* tok_slot; int* slot_tok; };

__device__ __forceinline__ unsigned f2bf(float f) { unsigned u = __builtin_bit_cast(unsigned, f); return (u + 0x7fffu + ((u >> 16) & 1u)) >> 16; }
__device__ __forceinline__ float bf2f(unsigned short b) { return __builtin_bit_cast(float, (unsigned)b << 16); }
__device__ __forceinline__ unsigned pk2(float lo, float hi) { return f2bf(lo) | (f2bf(hi) << 16); }
__device__ __forceinline__ float wave_sum(float v) {
#pragma unroll
    for (int o = 1; o < 64; o <<= 1) v += __shfl_xor(v, o);
    return v;
}

__global__ void __launch_bounds__(256) k_transpose(const float* __restrict__ W, bf16_t* __restrict__ Wt, int K, int N, int grp, int gstride, int goff, int pad_,
                                                   size_t src_bstride, size_t dst_bstride) {
    __shared__ float tile[32][33];
    W += (size_t)blockIdx.z * src_bstride; Wt += (size_t)blockIdx.z * dst_bstride;
    const int n0 = blockIdx.x * 32, k0 = blockIdx.y * 32, tx = threadIdx.x & 31, ty = threadIdx.x >> 5;
#pragma unroll
    for (int i = 0; i < 4; ++i) tile[ty + 8 * i][tx] = W[(size_t)(k0 + ty + 8 * i) * N + n0 + tx];
    __syncthreads();
#pragma unroll
    for (int i = 0; i < 4; ++i) { const int n = n0 + ty + 8 * i; const int dr = (n / grp) * gstride + goff + n % grp;
        Wt[(size_t)dr * K + k0 + tx] = (bf16_t)f2bf(tile[tx][ty + 8 * i]); }
}

__global__ void __launch_bounds__(256) k_rmsnorm(const float* __restrict__ x, const float* __restrict__ g, bf16_t* __restrict__ out) {
    const int lane = threadIdx.x & 63, row = blockIdx.x * 4 + (threadIdx.x >> 6);
    const f32x4* xr = (const f32x4*)(x + (size_t)row * D) + lane;
    f32x4 v[4]; float s = 0.f;
#pragma unroll
    for (int j = 0; j < 4; ++j) { v[j] = xr[64 * j]; s += v[j].x * v[j].x + v[j].y * v[j].y + v[j].z * v[j].z + v[j].w * v[j].w; }
    const float r = rsqrtf(wave_sum(s) * (1.f / D) + RMS_EPS);
    u32x2* o = (u32x2*)(out + (size_t)row * D) + lane;
#pragma unroll
    for (int j = 0; j < 4; ++j) { const f32x4 gg = ((const f32x4*)g)[lane + 64 * j]; u32x2 w; w.x = pk2(v[j].x * r * gg.x, v[j].y * r * gg.y); w.y = pk2(v[j].z * r * gg.z, v[j].w * r * gg.w); o[64 * j] = w; }
}

template <class Epi>
__global__ void __launch_bounds__(256) k_gemm(const bf16_t* __restrict__ A, const bf16_t* __restrict__ Bt, int K, int lda, int ldb, int pad_, Epi E) {
    const int lane = threadIdx.x & 63, wid = threadIdx.x >> 6, wr = wid >> 1, wc = wid & 1, fr = lane & 15, fq = lane >> 4;
    const int row0 = blockIdx.y * 128 + wr * 64, col0 = blockIdx.x * 128 + wc * 64;
    f32x4 acc[4][4];
#pragma unroll
    for (int m = 0; m < 4; ++m)
#pragma unroll
        for (int n = 0; n < 4; ++n) acc[m][n] = (f32x4){0.f, 0.f, 0.f, 0.f};
    const bf16_t* ap = A + (size_t)(row0 + fr) * lda + fq * 8;
    const bf16_t* bp = Bt + (size_t)(col0 + fr) * ldb + fq * 8;
    for (int k = 0; k < K; k += 32) {
        bf16x8 a[4], b[4];
#pragma unroll
        for (int m = 0; m < 4; ++m) a[m] = *(const bf16x8*)(ap + (size_t)m * 16 * lda + k);
#pragma unroll
        for (int n = 0; n < 4; ++n) b[n] = *(const bf16x8*)(bp + (size_t)n * 16 * ldb + k);
#pragma unroll
        for (int m = 0; m < 4; ++m)
#pragma unroll
            for (int n = 0; n < 4; ++n) acc[m][n] = __builtin_amdgcn_mfma_f32_16x16x32_bf16(b[n], a[m], acc[m][n], 0, 0, 0);
    }
#pragma unroll
    for (int m = 0; m < 4; ++m)
#pragma unroll
        for (int n = 0; n < 4; ++n) E(row0 + m * 16 + fr, col0 + n * 16 + fq * 4, acc[m][n]);
}
struct EpiStoreBf16 { bf16_t* C; int ldc; int pad_;
    __device__ __forceinline__ void operator()(int r, int c, f32x4 v) const { u32x2 w; w.x = pk2(v.x, v.y); w.y = pk2(v.z, v.w); *(u32x2*)(C + (size_t)r * ldc + c) = w; } };
struct EpiResidual { const float* base; float* out; int ldc; int pad_;
    __device__ __forceinline__ void operator()(int r, int c, f32x4 v) const { const f32x4 b = *(const f32x4*)(base + (size_t)r * ldc + c); *(f32x4*)(out + (size_t)r * ldc + c) = b + v; } };

__global__ void __launch_bounds__(256) k_qknorm(bf16_t* __restrict__ qkv, const float* __restrict__ qg, const float* __restrict__ kg) {
    const int lane = threadIdx.x & 63, tok = blockIdx.x * 4 + (threadIdx.x >> 6);
    bf16_t* p = qkv + (size_t)tok * 3072;
#pragma unroll
    for (int pass = 0; pass < 4; ++pass) {
        const int e0 = pass * 512 + lane * 8;
        u32x4 raw = *(const u32x4*)(p + e0);
        float v[8];
#pragma unroll
        for (int i = 0; i < 4; ++i) { v[2 * i] = bf2f((unsigned short)(raw[i] & 0xffff)); v[2 * i + 1] = bf2f((unsigned short)(raw[i] >> 16)); }
        float s = 0.f;
#pragma unroll
        for (int i = 0; i < 8; ++i) s += v[i] * v[i];
        s += __shfl_xor(s, 1); s += __shfl_xor(s, 2); s += __shfl_xor(s, 4);
        const float r = rsqrtf(s * (1.f / 64.f) + RMS_EPS);
        const float* g = (e0 < 1024 ? qg : kg) + (e0 & 63);
        u32x4 w;
#pragma unroll
        for (int i = 0; i < 4; ++i) w[i] = pk2(v[2 * i] * r * g[2 * i], v[2 * i + 1] * r * g[2 * i + 1]);
        *(u32x4*)(p + e0) = w;
    }
}

__global__ void __launch_bounds__(256) k_na_attn(const bf16_t* __restrict__ qkv, const float* __restrict__ rpb, bf16_t* __restrict__ ao) {
    const int lane = threadIdx.x & 63, tok = blockIdx.x * 4 + (threadIdx.x >> 6);
    const int b = tok >> 12, t = tok & 4095, r = t >> 6, c = t & 63, h = lane >> 2, sub = lane & 3;
    int rs = r - 4; rs = rs < 0 ? 0 : (rs > 56 ? 56 : rs);
    int cs = c - 8; cs = cs < 0 ? 0 : (cs > 48 ? 48 : cs);
    float q[16], o[16];
    { const bf16_t* qp = qkv + (size_t)tok * 3072 + h * 64 + sub * 16;
#pragma unroll
      for (int i = 0; i < 16; ++i) { q[i] = bf2f(qp[i]); o[i] = 0.f; } }
    float mx = -1e30f, l = 0.f;
    for (int i = 0; i < 8; ++i) for (int j = 0; j < 16; ++j) {
        const int kr = rs + i, kc = cs + j; const size_t kt = (size_t)(b * 4096 + kr * 64 + kc) * 3072;
        const bf16_t* kp = qkv + kt + 1024 + h * 64 + sub * 16; const bf16_t* vp = qkv + kt + 2048 + h * 64 + sub * 16;
        float d = 0.f;
#pragma unroll
        for (int e = 0; e < 16; ++e) d += q[e] * bf2f(kp[e]);
        d += __shfl_xor(d, 1); d += __shfl_xor(d, 2);
        const float s = d * 0.125f + rpb[(h * 15 + (kr - r + 7)) * 31 + (kc - c + 15)];
        const float mn = fmaxf(mx, s), sc = __expf(mx - mn), p = __expf(s - mn);
        l = l * sc + p; mx = mn;
#pragma unroll
        for (int e = 0; e < 16; ++e) o[e] = o[e] * sc + p * bf2f(vp[e]);
    }
    const float il = 1.f / l;
    bf16_t* op = ao + (size_t)tok * 1024 + h * 64 + sub * 16;
#pragma unroll
    for (int e = 0; e < 16; ++e) op[e] = (bf16_t)f2bf(o[e] * il);
}

__global__ void k_t5table(const float* __restrict__ rel_bias, float* __restrict__ tbl, const float* lq1, const float* lk1, const float* lq2, const float* lk2, float* lamp, float lambda_init, float pad_) {
    const int i = blockIdx.x * blockDim.x + threadIdx.x;
    if (i < 8191 * 8) {
        const int rel = i / 8 - 4095, h = i % 8, n = rel < 0 ? -rel : rel;
        int bk;
        if (n < 8) bk = n; else { bk = 8 + (n >= 12) + (n >= 16) + (n >= 23) + (n >= 32) + (n >= 46) + (n >= 64) + (n >= 91); }
        bk += rel > 0 ? 16 : 0;
        tbl[i] = rel_bias[bk * 8 + h];
    }
    if (i == 0) { float s1 = 0.f, s2 = 0.f; for (int e = 0; e < 64; ++e) { s1 += lq1[e] * lk1[e]; s2 += lq2[e] * lk2[e]; } lamp[0] = expf(s1) - expf(s2) + lambda_init; }
}

__global__ void __launch_bounds__(512) k_diff_attn(const bf16_t* __restrict__ qkv, const float* __restrict__ tbl, const float* __restrict__ lamp, const float* __restrict__ subg, bf16_t* __restrict__ ao, float one_minus_li, float pad_) {
    __shared__ __attribute__((aligned(16))) bf16_t kv[16][2048];
    const int lane = threadIdx.x & 63, w = threadIdx.x >> 6, tok = blockIdx.x * 8 + w;
    const int b = tok >> 12, tq = tok & 4095, h = lane >> 3, c = (lane >> 2) & 1, sub = lane & 3;
    float q[16], o[32];
    { const bf16_t* qp = qkv + (size_t)tok * 3072 + h * 128 + c * 64 + sub * 16;
#pragma unroll
      for (int i = 0; i < 16; ++i) q[i] = bf2f(qp[i]);
#pragma unroll
      for (int i = 0; i < 32; ++i) o[i] = 0.f; }
    float mx = -1e30f, l = 0.f;
    for (int k0 = 0; k0 < SEQ; k0 += 16) {
        __syncthreads();
#pragma unroll
        for (int i = 0; i < 8; ++i) { const int idx = threadIdx.x + 512 * i, key = idx >> 8, ch = idx & 255;
            *(u32x4*)(&kv[key][ch * 8]) = *(const u32x4*)(qkv + (size_t)(b * 4096 + k0 + key) * 3072 + 1024 + ch * 8); }
        __syncthreads();
        for (int kk = 0; kk < 16; ++kk) {
            const bf16_t* kp = &kv[kk][h * 128 + c * 64 + sub * 16];
            float d = 0.f;
#pragma unroll
            for (int e = 0; e < 16; ++e) d += q[e] * bf2f(kp[e]);
            d += __shfl_xor(d, 1); d += __shfl_xor(d, 2);
            const float s = d * 0.125f + tbl[(k0 + kk - tq + 4095) * 8 + h];
            const float mn = fmaxf(mx, s), sc = __expf(mx - mn), p = __expf(s - mn);
            l = l * sc + p; mx = mn;
            const bf16_t* vp = &kv[kk][1024 + h * 128 + sub * 32];
#pragma unroll
            for (int e = 0; e < 32; ++e) o[e] = o[e] * sc + p * bf2f(vp[e]);
        }
    }
    const float il = 1.f / l, lam = lamp[0];
    float ss = 0.f; float r[32];
#pragma unroll
    for (int e = 0; e < 32; ++e) { const float mine = o[e] * il; const float other = __shfl_xor(mine, 4); r[e] = mine - lam * other; ss += r[e] * r[e]; }
    ss += __shfl_xor(ss, 1); ss += __shfl_xor(ss, 2);
    const float rn = rsqrtf(ss * (1.f / 128.f) + RMS_EPS) * one_minus_li;
    if (c == 0) { bf16_t* op = ao + (size_t)tok * 1024 + h * 128 + sub * 32;
#pragma unroll
        for (int e = 0; e < 32; ++e) op[e] = (bf16_t)f2bf(r[e] * rn * subg[sub * 32 + e]); }
}

__global__ void __launch_bounds__(256) k_norm_router(const float* __restrict__ x, const float* __restrict__ g, const float* __restrict__ wg, const float* __restrict__ bg,
                                                     const float* __restrict__ we, const float* __restrict__ be, bf16_t* __restrict__ xn, TokArrays T, unsigned* __restrict__ cnt) {
    const int lane = threadIdx.x & 63, tok = blockIdx.x * 4 + (threadIdx.x >> 6);
    const f32x4* xr = (const f32x4*)(x + (size_t)tok * D) + lane;
    f32x4 v[4]; float s = 0.f;
#pragma unroll
    for (int j = 0; j < 4; ++j) { v[j] = xr[64 * j]; s += v[j].x * v[j].x + v[j].y * v[j].y + v[j].z * v[j].z + v[j].w * v[j].w; }
    const float r = rsqrtf(wave_sum(s) * (1.f / D) + RMS_EPS);
    float lg[20];
#pragma unroll
    for (int i = 0; i < 20; ++i) lg[i] = 0.f;
    u32x2* o = (u32x2*)(xn + (size_t)tok * D) + lane;
#pragma unroll
    for (int j = 0; j < 4; ++j) { const f32x4 gg = ((const f32x4*)g)[lane + 64 * j];
        float hv[4] = {v[j].x * r * gg.x, v[j].y * r * gg.y, v[j].z * r * gg.z, v[j].w * r * gg.w};
        u32x2 w; w.x = pk2(hv[0], hv[1]); w.y = pk2(hv[2], hv[3]); o[64 * j] = w;
#pragma unroll
        for (int e = 0; e < 4; ++e) { const int col = (lane + 64 * j) * 4 + e;
            const f32x4 wgv = *(const f32x4*)(wg + (size_t)col * 4);
            lg[0] += hv[e] * wgv.x; lg[1] += hv[e] * wgv.y; lg[2] += hv[e] * wgv.z; lg[3] += hv[e] * wgv.w;
#pragma unroll
            for (int q4 = 0; q4 < 4; ++q4) { const f32x4 wev = *(const f32x4*)(we + (size_t)col * 16 + q4 * 4);
                lg[4 + q4 * 4 + 0] += hv[e] * wev.x; lg[4 + q4 * 4 + 1] += hv[e] * wev.y; lg[4 + q4 * 4 + 2] += hv[e] * wev.z; lg[4 + q4 * 4 + 3] += hv[e] * wev.w; } } }
#pragma unroll
    for (int i = 0; i < 20; ++i) lg[i] = wave_sum(lg[i]);
    if (lane == 0) {
        float gl[4]; int gi = 0; float gm = -1e30f;
#pragma unroll
        for (int i = 0; i < 4; ++i) { gl[i] = lg[i] + bg[i]; if (gl[i] > gm) { gm = gl[i]; gi = i; } }
        float gs = 0.f;
#pragma unroll
        for (int i = 0; i < 4; ++i) gs += __expf(gl[i] - gm);
        const float gp = 1.f / gs;
        float el[4];
#pragma unroll
        for (int i = 0; i < 4; ++i) { float t = 0.f;
#pragma unroll
            for (int gq = 0; gq < 4; ++gq) t = (gq == gi) ? (lg[4 + gq * 4 + i] + be[gq * 4 + i]) : t;
            el[i] = t; }
        int i0 = 0; float m0 = el[0];
#pragma unroll
        for (int i = 1; i < 4; ++i) if (el[i] > m0) { m0 = el[i]; i0 = i; }
        int i1 = -1; float m1 = -1e30f;
#pragma unroll
        for (int i = 0; i < 4; ++i) if (i != i0 && el[i] > m1) { m1 = el[i]; i1 = i; }
        const float e1 = __expf(m1 - m0), w0 = gp / (1.f + e1), w1 = gp * e1 / (1.f + e1);
        const int E0 = gi * 4 + i0, E1 = gi * 4 + i1;
        T.tok_e[tok * 2] = E0; T.tok_e[tok * 2 + 1] = E1; T.tok_w[tok * 2] = w0; T.tok_w[tok * 2 + 1] = w1;
        atomicAdd(&cnt[E0], 1u); atomicAdd(&cnt[E1], 1u);
    }
}

struct MoeMap { int pstart[NE]; int ntiles; };
__device__ __forceinline__ void moe_offsets(const unsigned* cnt, int* pstart, int* pcount) {
    int acc = 0;
#pragma unroll
    for (int e = 0; e < NE; ++e) { const int c = (int)cnt[e]; pstart[e] = acc; pcount[e] = c; acc += (c + 255) / 256 * 256; }
}
__global__ void __launch_bounds__(256) k_assign(const unsigned* __restrict__ cnt, unsigned* __restrict__ cur, TokArrays T, int* __restrict__ tile_e) {
    int pstart[NE], pcount[NE]; moe_offsets(cnt, pstart, pcount);
    const int tok = blockIdx.x * 256 + threadIdx.x;
#pragma unroll
    for (int k = 0; k < 2; ++k) { const int e = T.tok_e[tok * 2 + k]; int ps = 0;
#pragma unroll
        for (int i = 0; i < NE; ++i) ps = (i == e) ? pstart[i] : ps;
        const int slot = ps + (int)atomicAdd(&cur[e], 1u); T.slot_tok[slot] = tok; T.tok_slot[tok * 2 + k] = slot; }
    if (blockIdx.x == 0) {
        for (int i = threadIdx.x; i < NE * 256; i += 256) { const int e = i >> 8, j = i & 255; int ps = 0, pc = 0;
#pragma unroll
            for (int q = 0; q < NE; ++q) { ps = (q == e) ? pstart[q] : ps; pc = (q == e) ? pcount[q] : pc; }
            const int padded = (pc + 255) / 256 * 256; if (pc + j < padded) T.slot_tok[ps + pc + j] = 0; }
        for (int tI = threadIdx.x; tI < MAXT + 1; tI += 256) { int e = -1;
#pragma unroll
            for (int q = 0; q < NE; ++q) { const int padded = (pcount[q] + 255) / 256 * 256; if (tI * 256 >= pstart[q] && tI * 256 < pstart[q] + padded) e = q; }
            tile_e[tI] = e; }
    }
}

__global__ void __launch_bounds__(256) k_moe_gateup(const bf16_t* __restrict__ xn, const bf16_t* __restrict__ wgu, const int* __restrict__ slot_tok, const int* __restrict__ tile_e, bf16_t* __restrict__ H) {
    const int lane = threadIdx.x & 63, wid = threadIdx.x >> 6, wr = wid >> 1, wc = wid & 1, fr = lane & 15, fq = lane >> 4;
    const int row0 = blockIdx.y * 128 + wr * 64; const int e = tile_e[row0 >> 8]; if (e < 0) return;
    const int hid0 = blockIdx.x * 64 + wc * 32;
    const int tile = hid0 >> 7, j0 = hid0 & 127;
    const bf16_t* B = wgu + (size_t)e * 1024 * 1024;
    f32x4 ag[4][2], au[4][2];
#pragma unroll
    for (int m = 0; m < 4; ++m)
#pragma unroll
        for (int n = 0; n < 2; ++n) { ag[m][n] = (f32x4){0.f, 0.f, 0.f, 0.f}; au[m][n] = (f32x4){0.f, 0.f, 0.f, 0.f}; }
    const bf16_t* ap[4];
#pragma unroll
    for (int m = 0; m < 4; ++m) ap[m] = xn + (size_t)slot_tok[row0 + m * 16 + fr] * 1024 + fq * 8;
    const bf16_t* bg = B + (size_t)(tile * 256 + j0 + fr) * 1024 + fq * 8;
    const bf16_t* bu = bg + (size_t)128 * 1024;
    for (int k = 0; k < 1024; k += 32) {
        bf16x8 a[4], g[2], u[2];
#pragma unroll
        for (int m = 0; m < 4; ++m) a[m] = *(const bf16x8*)(ap[m] + k);
#pragma unroll
        for (int n = 0; n < 2; ++n) { g[n] = *(const bf16x8*)(bg + (size_t)n * 16 * 1024 + k); u[n] = *(const bf16x8*)(bu + (size_t)n * 16 * 1024 + k); }
#pragma unroll
        for (int m = 0; m < 4; ++m)
#pragma unroll
            for (int n = 0; n < 2; ++n) { ag[m][n] = __builtin_amdgcn_mfma_f32_16x16x32_bf16(g[n], a[m], ag[m][n], 0, 0, 0); au[m][n] = __builtin_amdgcn_mfma_f32_16x16x32_bf16(u[n], a[m], au[m][n], 0, 0, 0); }
    }
#pragma unroll
    for (int m = 0; m < 4; ++m)
#pragma unroll
        for (int n = 0; n < 2; ++n) { float hv[4];
#pragma unroll
            for (int i = 0; i < 4; ++i) { const float gvv = ag[m][n][i]; hv[i] = gvv / (1.f + __expf(-gvv)) * au[m][n][i]; }
            u32x2 w; w.x = pk2(hv[0], hv[1]); w.y = pk2(hv[2], hv[3]);
            *(u32x2*)(H + (size_t)(row0 + m * 16 + fr) * 512 + hid0 + n * 16 + fq * 4) = w; }
}
__global__ void __launch_bounds__(256) k_moe_down(const bf16_t* __restrict__ H, const bf16_t* __restrict__ wd, const int* __restrict__ tile_e, bf16_t* __restrict__ Y) {
    const int lane = threadIdx.x & 63, wid = threadIdx.x >> 6, wr = wid >> 1, wc = wid & 1, fr = lane & 15, fq = lane >> 4;
    const int row0 = blockIdx.y * 128 + wr * 64, col0 = blockIdx.x * 128 + wc * 64; const int e = tile_e[row0 >> 8]; if (e < 0) return;
    const bf16_t* Bt = wd + (size_t)e * 1024 * 512;
    f32x4 acc[4][4];
#pragma unroll
    for (int m = 0; m < 4; ++m)
#pragma unroll
        for (int n = 0; n < 4; ++n) acc[m][n] = (f32x4){0.f, 0.f, 0.f, 0.f};
    const bf16_t* ap = H + (size_t)(row0 + fr) * 512 + fq * 8; const bf16_t* bp = Bt + (size_t)(col0 + fr) * 512 + fq * 8;
    for (int k = 0; k < 512; k += 32) {
        bf16x8 a[4], b[4];
#pragma unroll
        for (int m = 0; m < 4; ++m) a[m] = *(const bf16x8*)(ap + (size_t)m * 16 * 512 + k);
#pragma unroll
        for (int n = 0; n < 4; ++n) b[n] = *(const bf16x8*)(bp + (size_t)n * 16 * 512 + k);
#pragma unroll
        for (int m = 0; m < 4; ++m)
#pragma unroll
            for (int n = 0; n < 4; ++n) acc[m][n] = __builtin_amdgcn_mfma_f32_16x16x32_bf16(b[n], a[m], acc[m][n], 0, 0, 0);
    }
#pragma unroll
    for (int m = 0; m < 4; ++m)
#pragma unroll
        for (int n = 0; n < 4; ++n) { u32x2 w; w.x = pk2(acc[m][n].x, acc[m][n].y); w.y = pk2(acc[m][n].z, acc[m][n].w);
            *(u32x2*)(Y + (size_t)(row0 + m * 16 + fr) * 1024 + col0 + n * 16 + fq * 4) = w; }
}
__global__ void __launch_bounds__(256) k_combine(float* __restrict__ x, const bf16_t* __restrict__ Y, TokArrays T, const float* __restrict__ gnext, bf16_t* __restrict__ xn) {
    const int lane = threadIdx.x & 63, tok = blockIdx.x * 4 + (threadIdx.x >> 6);
    const int s0 = T.tok_slot[tok * 2], s1 = T.tok_slot[tok * 2 + 1]; const float w0 = T.tok_w[tok * 2], w1 = T.tok_w[tok * 2 + 1];
    f32x4* xr = (f32x4*)(x + (size_t)tok * D) + lane;
    const u32x2* y0 = (const u32x2*)(Y + (size_t)s0 * D) + lane; const u32x2* y1 = (const u32x2*)(Y + (size_t)s1 * D) + lane;
    f32x4 v[4]; float s = 0.f;
#pragma unroll
    for (int j = 0; j < 4; ++j) { v[j] = xr[64 * j]; const u32x2 a = y0[64 * j], b = y1[64 * j];
        v[j].x += w0 * bf2f(a.x & 0xffff) + w1 * bf2f(b.x & 0xffff); v[j].y += w0 * bf2f(a.x >> 16) + w1 * bf2f(b.x >> 16);
        v[j].z += w0 * bf2f(a.y & 0xffff) + w1 * bf2f(b.y & 0xffff); v[j].w += w0 * bf2f(a.y >> 16) + w1 * bf2f(b.y >> 16);
        xr[64 * j] = v[j]; s += v[j].x * v[j].x + v[j].y * v[j].y + v[j].z * v[j].z + v[j].w * v[j].w; }
    if (gnext) { const float r = rsqrtf(wave_sum(s) * (1.f / D) + RMS_EPS); u32x2* o = (u32x2*)(xn + (size_t)tok * D) + lane;
#pragma unroll
        for (int j = 0; j < 4; ++j) { const f32x4 gg = ((const f32x4*)gnext)[lane + 64 * j]; u32x2 w; w.x = pk2(v[j].x * r * gg.x, v[j].y * r * gg.y); w.y = pk2(v[j].z * r * gg.z, v[j].w * r * gg.w); o[64 * j] = w; } }
}

#define LAS __attribute__((address_space(3)))
#define GAS __attribute__((address_space(1)))
typedef GAS const float* gcf_t; typedef GAS float* gf_t; typedef GAS const bf16_t* gcb_t; typedef GAS bf16_t* gb_t; typedef GAS const int* gci_t; typedef GAS int* gi_t;
typedef int v8i32 __attribute__((ext_vector_type(8)));
typedef GAS unsigned* gu_t; typedef GAS const unsigned* gcu_t; typedef GAS const char* gcc_t; typedef GAS unsigned char* guc_t;
struct TokG { gi_t tok_e; gf_t tok_w; gi_t tok_slot; gi_t slot_tok; };
#define DI __device__ __forceinline__
typedef short s16x4 __attribute__((ext_vector_type(4)));
typedef float f32x16 __attribute__((ext_vector_type(16)));
typedef float f32x2_t __attribute__((ext_vector_type(2)));
typedef __bf16 bf16x2_t __attribute__((ext_vector_type(2)));
constexpr float LOG2E = 1.4426950408889634f;
constexpr int NWAVES = 8, NTHREADS = 512;
constexpr size_t WS_WQKVP = 381 * MiB;
constexpr size_t WS_X16 = 388 * MiB;
constexpr size_t WS_END2 = 452 * MiB;
constexpr int CW_BAR = 16384;
constexpr int RING_BYTES = 131072;
constexpr int MISC_OFF = 147456;
constexpr int ROWS_OFF = MISC_OFF + 1024;
constexpr int LDS_BYTES = 155648;

DI unsigned cvtpk(float lo, float hi) { f32x2_t v = {lo, hi}; bf16x2_t b = __builtin_convertvector(v, bf16x2_t); return __builtin_bit_cast(unsigned, b); }
DI float uni(float v) { return __builtin_bit_cast(float, __builtin_amdgcn_readfirstlane(__builtin_bit_cast(int, v))); }
DI int fresh_lane() { int l; asm volatile("v_mbcnt_lo_u32_b32 %0, -1, 0\n\tv_mbcnt_hi_u32_b32 %0, -1, %0" : "=v"(l)); return l; }
#define SWZ_XOR(v, k) __builtin_bit_cast(float, __builtin_amdgcn_ds_swizzle(__builtin_bit_cast(int, (v)), ((k) << 10) | 0x1f))
DI float wave_max(float v) {
#pragma unroll
    for (int o = 1; o < 64; o <<= 1) v = fmaxf(v, __shfl_xor(v, o));
    return v;
}

#define XB_TMO      128
#define XB_XCNT(j)  (256  + 64 * (j))
#define XB_XSUB(j)  (1280 + 64 * (j))
#define XB_XGEN(j)  (2304 + 64 * (j))
#define XB_TOP      3328
#define XB_TOPGEN   3392
#define XCD_BAR_WORDS 3456
#define XB_SPIN_CAP (1u << 18)
DI unsigned xb_ld(unsigned* p)              { return __hip_atomic_load(p, __ATOMIC_RELAXED, __HIP_MEMORY_SCOPE_AGENT); }
DI unsigned xb_add(unsigned* p, unsigned v) { return __hip_atomic_fetch_add(p, v, __ATOMIC_RELAXED, __HIP_MEMORY_SCOPE_AGENT); }
DI unsigned xb_xcc_id() { return (unsigned)__builtin_amdgcn_s_getreg((3 << 11) | 20) & 0xFu; }
#define XB_SPIN(cond, bar) do { unsigned _sp = 0; while (cond) { __builtin_amdgcn_s_sleep(1); \
    if ((++_sp & 255u) == 0u) { if (xb_ld(&(bar)[XB_TMO])) break; if (_sp > XB_SPIN_CAP) { atomicAdd(&(bar)[XB_TMO], 1u); break; } } } } while (0)
struct XcdBarrier { unsigned* bar; unsigned x; volatile LAS unsigned* st; int wave; };
DI XcdBarrier xcd_barrier_post(unsigned* bar, volatile LAS unsigned* st, int wave) {
    XcdBarrier b; b.bar = bar; b.x = xb_xcc_id(); b.st = st; b.wave = wave;
    if (wave == 0 && fresh_lane() == 0) (void)xb_add(&bar[XB_XCNT(b.x)], 1u);
    return b;
}
DI void xcd_barrier_complete(unsigned* bar, unsigned x, unsigned& nloc, unsigned& nx) {
    const unsigned G = gridDim.x * gridDim.y * gridDim.z;
    unsigned sum, cnt, mine, sp = 0u;
    for (;;) {
        sum = 0u; cnt = 0u; mine = 0u;
#pragma unroll
        for (unsigned j = 0; j < 16; ++j) { const unsigned c = xb_ld(&bar[XB_XCNT(j)]); sum += c; cnt += (c > 0u) ? 1u : 0u; mine = (j == x) ? c : mine; }
        if (sum == G) break;
        __builtin_amdgcn_s_sleep(1);
        if ((++sp & 255u) == 0u) { if (xb_ld(&bar[XB_TMO])) break; if (sp > XB_SPIN_CAP) { atomicAdd(&bar[XB_TMO], 1u); break; } }
    }
    nloc = mine > 0u ? mine : 1u; nx = cnt > 0u ? cnt : 1u;
}
DI void xcd_barrier(const XcdBarrier& b) {
    asm volatile("s_waitcnt vmcnt(0)" ::: "memory");
    __syncthreads();
    if (b.wave == 0 && fresh_lane() == 0) {
        unsigned* bar = b.bar;
        __builtin_amdgcn_s_waitcnt(0);
        unsigned nloc = b.st[0], nx = b.st[1];
        if (nloc == 0u) { xcd_barrier_complete(bar, b.x, nloc, nx); b.st[0] = nloc; b.st[1] = nx; }
        const unsigned old = xb_add(&bar[XB_XSUB(b.x)], 1u);
        const unsigned gen = old / nloc;
        if (old + 1u == (gen + 1u) * nloc) {
            __builtin_amdgcn_fence(__ATOMIC_RELEASE, "agent");
            asm volatile("s_waitcnt vmcnt(0)" ::: "memory");
            const unsigned og = xb_add(&bar[XB_TOP], 1u);
            const unsigned tg = og / nx;
            if (og + 1u == (tg + 1u) * nx) xb_add(&bar[XB_TOPGEN], 1u);
            else XB_SPIN(xb_ld(&bar[XB_TOPGEN]) == tg, bar);
            __builtin_amdgcn_fence(__ATOMIC_ACQUIRE, "agent");
            xb_add(&bar[XB_XGEN(b.x)], 1u);
            asm volatile("s_waitcnt vmcnt(0)" ::: "memory");
        } else {
            XB_SPIN(xb_ld(&bar[XB_XGEN(b.x)]) == gen, bar);
            __builtin_amdgcn_fence(__ATOMIC_ACQUIRE, "agent");
            asm volatile("s_waitcnt vmcnt(0)" ::: "memory");
        }
    }
    __syncthreads();
}

namespace pg8 {
constexpr int BM = 256, BK = 64, HALF = 128, HTB = HALF * BK * 2, STAGE_BYTES = 8 * HTB, NXCD = 8, WGM = 8;
DI int lds_byte(int r, int c) { const int st = (r >> 4) * 2 + (c >> 5), rr = r & 15, cc = c & 31, ob = rr * 64 + cc * 2; return st * 1024 + (ob ^ (((ob >> 9) & 1) << 5)); }
DI void stage_rc(int b, int& R, int& C) { const int st = b / 1024, sb = b % 1024, swz = sb ^ (((sb >> 9) & 1) << 5); R = (st >> 1) * 16 + swz / 64; C = (st & 1) * 32 + (swz % 64) / 2; }
DI int perm32(int rho) { const int n = rho >> 4, i = rho & 15; return 8 * (i >> 2) + 4 * n + (i & 3); }

struct Unit { int pm, pn; gcc_t A; gcc_t B; };

struct DenseOrder {
    int nM, nN, nwg, G, c, K; gcc_t A; gcc_t B;
    DI void init(int M_, int N_, int K_, int G_, int c_, gcc_t A_, gcc_t B_) { nM = M_ / BM; nN = N_ / BM; nwg = nM * nN; G = G_; c = c_; K = K_; A = A_; B = B_; }
    DI bool next(int i, Unit& u) const {
        const long L = (long)i * G + c; if (L >= nwg) return false;
        int wgid = (int)L; { const int q = nwg / NXCD, r = nwg % NXCD, xcd = wgid % NXCD, off = wgid / NXCD; wgid = (xcd < r ? xcd * (q + 1) : r * (q + 1) + (xcd - r) * q) + off; }
        const int nig = WGM * nN, gid = wgid / nig, fm = gid * WGM, gsz = (nM - fm) < WGM ? (nM - fm) : WGM;
        u.pm = fm + ((wgid % nig) % gsz); u.pn = (wgid % nig) / gsz;
        u.A = A + (size_t)u.pm * BM * K * 2; u.B = B + (size_t)u.pn * BM * K * 2; return true;
    }
};
struct MoeOrder {
    int nunits, G, vc, K; gcc_t A; gcc_t B; size_t bstride; const LAS int* tend; bool gather;
    DI bool next(int i, Unit& u) const {
        const int L = i * G + vc; if (L >= nunits) return false;
        const int rt = L >> 2; u.pm = rt; u.pn = L & 3; int e = 0;
#pragma unroll
        for (int j = 0; j < 15; ++j) e += (tend[j] <= rt) ? 1 : 0;
        u.B = B + (size_t)e * bstride + (size_t)u.pn * BM * K * 2;
        u.A = gather ? A : A + (size_t)rt * BM * K * 2; return true;
    }
};

struct EpiQKV {
    static constexpr bool PERM = true;
    gb_t O; gcf_t qg; gcf_t kg; gcf_t rs; float qscale; guc_t q8; guc_t k8;
    DI void operator()(const f32x4 (&acc)[2][2][4][2], const Unit& u, int wr, int wc, int fr, int fq) const {
        const int row0 = u.pm * BM + wr * 64 + fr, colb = u.pn * BM + 64 * wc + 8 * fq;
        const bool nrm = u.pn < 8; gcf_t g = (u.pn < 4 ? qg : kg) + 8 * fq;
        f32x4 gv[2][2];
#pragma unroll
        for (int bj = 0; bj < 2; ++bj)
#pragma unroll
            for (int n = 0; n < 2; ++n) { gv[bj][n] = nrm ? *(const GAS f32x4*)(g + 32 * bj + 4 * n) : (f32x4){1.f, 1.f, 1.f, 1.f}; if (u.pn < 4) gv[bj][n] *= qscale; }
        float rsa[2][4];
#pragma unroll
        for (int ai = 0; ai < 2; ++ai)
#pragma unroll
            for (int m = 0; m < 4; ++m) rsa[ai][m] = rs[row0 + ai * HALF + m * 16];
        asm volatile("" : "+v"(rsa[0][0]), "+v"(rsa[0][1]), "+v"(rsa[0][2]), "+v"(rsa[0][3]), "+v"(rsa[1][0]), "+v"(rsa[1][1]), "+v"(rsa[1][2]), "+v"(rsa[1][3]));
        float ssr[8];
#pragma unroll
        for (int i = 0; i < 8; ++i) { float t = 0.f;
#pragma unroll
            for (int bj = 0; bj < 2; ++bj)
#pragma unroll
                for (int n = 0; n < 2; ++n) { const f32x4 q = acc[i >> 2][bj][i & 3][n] * acc[i >> 2][bj][i & 3][n]; t += (q[0] + q[1]) + (q[2] + q[3]); }
            ssr[i] = t; }
        if (nrm) {
#pragma unroll
            for (int i = 0; i < 8; ++i) ssr[i] += __shfl_xor(ssr[i], 16);
#pragma unroll
            for (int i = 0; i < 8; ++i) ssr[i] += __shfl_xor(ssr[i], 32);
        }
#pragma unroll
        for (int ai = 0; ai < 2; ++ai)
#pragma unroll
            for (int m = 0; m < 4; ++m) {
                const float rsv = rsa[ai][m];
                const float sc = nrm ? rsv * rsqrtf(rsv * rsv * ssr[ai * 4 + m] * (1.f / 64.f) + RMS_EPS) : rsv;
                gb_t rowp = O + (size_t)(row0 + ai * HALF + m * 16) * 3072 + colb;
#pragma unroll
                for (int bj = 0; bj < 2; ++bj) { const f32x4 a = acc[ai][bj][m][0] * sc * gv[bj][0], b = acc[ai][bj][m][1] * sc * gv[bj][1];
                    if (q8 && nrm) {
                        int w0 = 0, w1 = 0;
                        w0 = __builtin_amdgcn_cvt_pk_fp8_f32(a[0], a[1], w0, false); w0 = __builtin_amdgcn_cvt_pk_fp8_f32(a[2], a[3], w0, true);
                        w1 = __builtin_amdgcn_cvt_pk_fp8_f32(b[0], b[1], w1, false); w1 = __builtin_amdgcn_cvt_pk_fp8_f32(b[2], b[3], w1, true);
                        guc_t d8 = (u.pn < 4 ? q8 : k8) + (size_t)(row0 + ai * HALF + m * 16) * 1024 + (colb & 1023) + 32 * bj;
                        u32x2 w8; w8.x = (unsigned)w0; w8.y = (unsigned)w1; *(GAS u32x2*)d8 = w8;
                    } else {
                    u32x4 w; w.x = cvtpk(a[0], a[1]); w.y = cvtpk(a[2], a[3]); w.z = cvtpk(b[0], b[1]); w.w = cvtpk(b[2], b[3]);
                    *(GAS u32x4*)(rowp + 32 * bj) = w; } }
            }
    }
};
template <bool BASE16> struct EpiRes {
    static constexpr bool PERM = true;
    gcf_t base32; gcb_t base16; gb_t out;
    DI void operator()(const f32x4 (&acc)[2][2][4][2], const Unit& u, int wr, int wc, int fr, int fq) const {
        const int row0 = u.pm * BM + wr * 64 + fr, col0 = u.pn * BM + wc * 32 + 8 * fq;
        if constexpr (BASE16) {
            u32x4 r[2][4][2];
#pragma unroll
            for (int ai = 0; ai < 2; ++ai)
#pragma unroll
                for (int m = 0; m < 4; ++m)
#pragma unroll
                    for (int bj = 0; bj < 2; ++bj) r[ai][m][bj] = *(const GAS u32x4*)(base16 + (size_t)(row0 + ai * HALF + m * 16) * D + col0 + bj * HALF);
            asm volatile("" : "+v"(r[0][0][0]), "+v"(r[0][0][1]), "+v"(r[0][1][0]), "+v"(r[0][1][1]), "+v"(r[0][2][0]), "+v"(r[0][2][1]), "+v"(r[0][3][0]), "+v"(r[0][3][1]));
            asm volatile("" : "+v"(r[1][0][0]), "+v"(r[1][0][1]), "+v"(r[1][1][0]), "+v"(r[1][1][1]), "+v"(r[1][2][0]), "+v"(r[1][2][1]), "+v"(r[1][3][0]), "+v"(r[1][3][1]));
#pragma unroll
            for (int ai = 0; ai < 2; ++ai)
#pragma unroll
                for (int m = 0; m < 4; ++m) { const size_t off = (size_t)(row0 + ai * HALF + m * 16) * D + col0;
#pragma unroll
                    for (int bj = 0; bj < 2; ++bj) { const u32x4 rr = r[ai][m][bj];
                        const f32x4 b0 = (f32x4){bf2f((unsigned short)(rr.x & 0xffffu)), bf2f((unsigned short)(rr.x >> 16)), bf2f((unsigned short)(rr.y & 0xffffu)), bf2f((unsigned short)(rr.y >> 16))};
                        const f32x4 b1 = (f32x4){bf2f((unsigned short)(rr.z & 0xffffu)), bf2f((unsigned short)(rr.z >> 16)), bf2f((unsigned short)(rr.w & 0xffffu)), bf2f((unsigned short)(rr.w >> 16))};
                        const f32x4 v0 = b0 + acc[ai][bj][m][0], v1 = b1 + acc[ai][bj][m][1];
                        u32x4 w; w.x = cvtpk(v0[0], v0[1]); w.y = cvtpk(v0[2], v0[3]); w.z = cvtpk(v1[0], v1[1]); w.w = cvtpk(v1[2], v1[3]);
                        *(GAS u32x4*)(out + off + bj * HALF) = w; } }
        } else {
#pragma unroll
            for (int ai = 0; ai < 2; ++ai) {
#pragma unroll
                for (int m = 0; m < 4; ++m) { const size_t off = (size_t)(row0 + ai * HALF + m * 16) * D + col0;
#pragma unroll
                    for (int bj = 0; bj < 2; ++bj) { const f32x4 b0 = *(const GAS f32x4*)(base32 + off + bj * HALF), b1 = *(const GAS f32x4*)(base32 + off + bj * HALF + 4);
                        const f32x4 v0 = b0 + acc[ai][bj][m][0], v1 = b1 + acc[ai][bj][m][1];
                        u32x4 w; w.x = cvtpk(v0[0], v0[1]); w.y = cvtpk(v0[2], v0[3]); w.z = cvtpk(v1[0], v1[1]); w.w = cvtpk(v1[2], v1[3]);
                        *(GAS u32x4*)(out + off + bj * HALF) = w; } }
            }
        }
    }
};
struct EpiGateUp {
    static constexpr bool PERM = true;
    gb_t H; gcf_t srs;
    DI void operator()(const f32x4 (&acc)[2][2][4][2], const Unit& u, int wr, int wc, int fr, int fq) const {
        const int row0 = u.pm * BM + wr * 64 + fr, col0 = u.pn * 128 + wc * 32 + 8 * fq;
        float rsa[2][4];
#pragma unroll
        for (int ai = 0; ai < 2; ++ai)
#pragma unroll
            for (int m = 0; m < 4; ++m) rsa[ai][m] = srs[row0 + ai * HALF + m * 16];
        asm volatile("" : "+v"(rsa[0][0]), "+v"(rsa[0][1]), "+v"(rsa[0][2]), "+v"(rsa[0][3]), "+v"(rsa[1][0]), "+v"(rsa[1][1]), "+v"(rsa[1][2]), "+v"(rsa[1][3]));
#pragma unroll
        for (int ai = 0; ai < 2; ++ai)
#pragma unroll
            for (int m = 0; m < 4; ++m) { float hv[8]; const float rsv = rsa[ai][m];
#pragma unroll
                for (int n = 0; n < 2; ++n)
#pragma unroll
                    for (int i = 0; i < 4; ++i) { const float gvv = acc[ai][0][m][n][i] * rsv; hv[4 * n + i] = gvv * __builtin_amdgcn_rcpf(1.f + __builtin_amdgcn_exp2f(-gvv * LOG2E)) * (acc[ai][1][m][n][i] * rsv); }
                u32x4 w; w.x = cvtpk(hv[0], hv[1]); w.y = cvtpk(hv[2], hv[3]); w.z = cvtpk(hv[4], hv[5]); w.w = cvtpk(hv[6], hv[7]);
                *(GAS u32x4*)(H + (size_t)(row0 + ai * HALF + m * 16) * DE + col0) = w; }
    }
};
struct EpiBf16 {
    static constexpr bool PERM = true;
    gb_t O; int ldc;
    DI void operator()(const f32x4 (&acc)[2][2][4][2], const Unit& u, int wr, int wc, int fr, int fq) const {
        const int row0 = u.pm * BM + wr * 64 + fr, col0 = u.pn * BM + wc * 32 + 8 * fq;
#pragma unroll
        for (int ai = 0; ai < 2; ++ai)
#pragma unroll
            for (int m = 0; m < 4; ++m) { gb_t rowp = O + (size_t)(row0 + ai * HALF + m * 16) * ldc + col0;
#pragma unroll
                for (int bj = 0; bj < 2; ++bj) { const f32x4 v0 = acc[ai][bj][m][0], v1 = acc[ai][bj][m][1];
                    u32x4 w; w.x = cvtpk(v0[0], v0[1]); w.y = cvtpk(v0[2], v0[3]); w.z = cvtpk(v1[0], v1[1]); w.w = cvtpk(v1[2], v1[3]);
                    *(GAS u32x4*)(rowp + bj * HALF) = w; } }
    }
};

template <class Epi, class Sched, bool GATHER>
DI void gemm_phase(const int tid, LAS unsigned char* lds, const int K, const Sched& S, const Epi& E, const LAS int* rows_lds) {
    const int wid = __builtin_amdgcn_readfirstlane(tid >> 6), lane = tid & 63, wr = wid >> 2, wc = wid & 3, fr = lane & 15, fq = lane >> 4;
    const int nt = K / BK;
    unsigned voffA[2], voffB[2]; int R0 = 0, C0 = 0;
#pragma unroll
    for (int i = 0; i < 2; ++i) { int R, C; stage_rc(tid * 16 + i * 8192, R, C); const int Rb = Epi::PERM ? ((R & ~31) + perm32(R & 31)) : R;
        voffA[i] = (unsigned)(R * K + C) * 2u; voffB[i] = (unsigned)(Rb * K + C) * 2u; if (i == 0) { R0 = R; C0 = C; } }
    const size_t kstep = (size_t)(BK * 2);
    const size_t hstep = (size_t)HALF * K * 2;
    const unsigned ldsw = (unsigned)wid * 1024u;
    const int aoff = lds_byte(wr * 64 + fr, fq * 8), boff = lds_byte(wc * 32 + fr, fq * 8);
#define PG8_SA(b, h) (((b) * 2 + (h)) * HTB)
#define PG8_SB(b, h) ((4 + (b) * 2 + (h)) * HTB)
#define PG8_STAGE(bufoff, gbase, voff) do { _Pragma("unroll") for (int _i = 0; _i < 2; ++_i) \
        __builtin_amdgcn_global_load_lds((const GAS unsigned*)((gcc_t)(gbase) + (voff)[_i]), (LAS unsigned*)(lds + (bufoff) + ldsw + _i * 8192), 16, 0, 0); } while (0)
#define PG8_STAGE_A(bufoff, kbase, h, GV) do { if constexpr (GATHER) { PG8_STAGE(bufoff, kbase, GV[h]); } else { PG8_STAGE(bufoff, (kbase) + (h) * hstep, voffA); } } while (0)
#define PG8_LDA(dst, b, h) do { _Pragma("unroll") for (int m = 0; m < 4; ++m) _Pragma("unroll") for (int k = 0; k < 2; ++k) dst[m][k] = *(const LAS bf16x8*)(lds + PG8_SA(b, h) + aoff + m * 2048 + k * 1024); } while (0)
#define PG8_LDB(dst, b, h) do { _Pragma("unroll") for (int n = 0; n < 2; ++n) _Pragma("unroll") for (int k = 0; k < 2; ++k) dst[n][k] = *(const LAS bf16x8*)(lds + PG8_SB(b, h) + boff + n * 2048 + k * 1024); } while (0)
#define PG8_MMA(ai, bj, At, Bt) do { __builtin_amdgcn_s_setprio(1); _Pragma("unroll") for (int m = 0; m < 4; ++m) _Pragma("unroll") for (int n = 0; n < 2; ++n) _Pragma("unroll") for (int k = 0; k < 2; ++k) \
        acc[ai][bj][m][n] = __builtin_amdgcn_mfma_f32_16x16x32_bf16(Bt[n][k], At[m][k], acc[ai][bj][m][n], 0, 0, 0); __builtin_amdgcn_s_setprio(0); } while (0)
#define PG8_WAIT_V(n) asm volatile("s_waitcnt vmcnt(" #n ")" ::: "memory")
#define PG8_WAIT_L(n) asm volatile("s_waitcnt lgkmcnt(" #n ")" ::: "memory")
#define PG8_BAR __builtin_amdgcn_s_barrier()
#define PG8_SCHED __builtin_amdgcn_sched_barrier(0)
#define PG8_ROWS(dst, ui_) do { int R0_, C0_; stage_rc((wid * 64 + fresh_lane()) * 16, R0_, C0_); _Pragma("unroll") for (int _h = 0; _h < 2; ++_h) _Pragma("unroll") for (int _j = 0; _j < 2; ++_j) \
        dst[_h][_j] = (unsigned)(rows_lds[(ui_) * 256 + _h * 128 + R0_ + 64 * _j] * K + C0_) * 2u; } while (0)
    Unit cur, nxt; int ui = 0;
    if (!S.next(0, cur)) return;
    f32x4 acc[2][2][4][2];
#pragma unroll
    for (int a = 0; a < 2; ++a)
#pragma unroll
        for (int b = 0; b < 2; ++b)
#pragma unroll
            for (int m = 0; m < 4; ++m)
#pragma unroll
                for (int n = 0; n < 2; ++n) acc[a][b][m][n] = (f32x4){0.f, 0.f, 0.f, 0.f};
    bf16x8 At[4][2], B0[2][2], B1[2][2];
    gcc_t cA = cur.A; gcc_t cB = cur.B;
    unsigned gC[2][2] = {{0u, 0u}, {0u, 0u}}, gN[2][2] = {{0u, 0u}, {0u, 0u}};
    if constexpr (GATHER) { PG8_ROWS(gC, 0); }
    PG8_STAGE(PG8_SB(0, 0), cB, voffB); PG8_STAGE(PG8_SB(0, 1), cB + hstep, voffB); PG8_STAGE_A(PG8_SA(0, 0), cA, 0, gC); PG8_STAGE_A(PG8_SA(0, 1), cA, 1, gC);
    if (wr == 1) PG8_BAR;
    PG8_WAIT_V(2); PG8_BAR;
    PG8_STAGE(PG8_SB(1, 0), cB + kstep, voffB); PG8_STAGE_A(PG8_SA(1, 0), cA + kstep, 0, gC); PG8_STAGE(PG8_SB(1, 1), cB + hstep + kstep, voffB);
    PG8_WAIT_V(6); PG8_BAR;
    for (;;) {
        const bool has_next = S.next(ui + 1, nxt);
        gcc_t nA = has_next ? nxt.A : cA; gcc_t nB = has_next ? nxt.B : cB;
        if constexpr (GATHER) { if (has_next) { PG8_ROWS(gN, ui + 1); } else {
#pragma unroll
            for (int h = 0; h < 2; ++h)
#pragma unroll
                for (int j = 0; j < 2; ++j) gN[h][j] = gC[h][j]; } }
        for (int t = 0; t < nt; t += 2) {
            const bool last = (t == nt - 2);
            gcc_t a1 = cA + (size_t)(t + 1) * kstep;
            gcc_t a2 = last ? nA : cA + (size_t)(t + 2) * kstep; gcc_t b2 = last ? nB : cB + (size_t)(t + 2) * kstep;
            gcc_t a3 = a2 + kstep; gcc_t b3 = b2 + kstep;
            unsigned g2[2][2];
#pragma unroll
            for (int h = 0; h < 2; ++h)
#pragma unroll
                for (int j = 0; j < 2; ++j) g2[h][j] = last ? gN[h][j] : gC[h][j];
            PG8_LDB(B0, 0, 0); PG8_LDB(B1, 0, 1); PG8_SCHED; PG8_LDA(At, 0, 0); PG8_STAGE_A(PG8_SA(1, 1), a1, 1, gC);
            PG8_WAIT_V(8); PG8_WAIT_L(0); PG8_BAR; PG8_MMA(0, 0, At, B0); PG8_MMA(0, 1, At, B1); PG8_BAR; PG8_SCHED;
            PG8_LDA(At, 0, 1); PG8_STAGE(PG8_SB(0, 0), b2, voffB); PG8_STAGE(PG8_SB(0, 1), b2 + hstep, voffB); PG8_STAGE_A(PG8_SA(0, 0), a2, 0, g2);
            PG8_WAIT_V(8); PG8_WAIT_L(0); PG8_BAR; PG8_MMA(1, 0, At, B0); PG8_MMA(1, 1, At, B1); PG8_BAR; PG8_SCHED;
            PG8_LDB(B0, 1, 0); PG8_LDB(B1, 1, 1); PG8_SCHED; PG8_LDA(At, 1, 0); PG8_STAGE_A(PG8_SA(0, 1), a2, 1, g2);
            PG8_WAIT_V(8); PG8_WAIT_L(0); PG8_BAR; PG8_MMA(0, 0, At, B0); PG8_MMA(0, 1, At, B1); PG8_BAR; PG8_SCHED;
            PG8_LDA(At, 1, 1); PG8_STAGE(PG8_SB(1, 0), b3, voffB); PG8_STAGE(PG8_SB(1, 1), b3 + hstep, voffB); PG8_STAGE_A(PG8_SA(1, 0), a3, 0, g2);
            PG8_WAIT_V(8); PG8_WAIT_L(0); PG8_BAR; PG8_MMA(1, 0, At, B0); PG8_MMA(1, 1, At, B1); PG8_BAR; PG8_SCHED;
        }
        if (wr == 0) PG8_BAR;
        E(acc, cur, wr, wc, fr, fq);
        if (!has_next) break;
#pragma unroll
        for (int a = 0; a < 2; ++a)
#pragma unroll
            for (int b = 0; b < 2; ++b)
#pragma unroll
                for (int m = 0; m < 4; ++m)
#pragma unroll
                    for (int n = 0; n < 2; ++n) acc[a][b][m][n] = (f32x4){0.f, 0.f, 0.f, 0.f};
        cur = nxt; cA = nA; cB = nB; ++ui;
        if constexpr (GATHER) {
#pragma unroll
            for (int h = 0; h < 2; ++h)
#pragma unroll
                for (int j = 0; j < 2; ++j) gC[h][j] = gN[h][j]; }
        if (wr == 1) PG8_BAR;
    }
    PG8_WAIT_V(0);
    PG8_BAR;
#undef PG8_SA
#undef PG8_SB
#undef PG8_STAGE
#undef PG8_STAGE_A
#undef PG8_LDA
#undef PG8_LDB
#undef PG8_MMA
#undef PG8_WAIT_V
#undef PG8_WAIT_L
#undef PG8_BAR
#undef PG8_SCHED
#undef PG8_ROWS
}
}

struct Args { const float* in[25]; float* out; unsigned char* ws; int ph_lo, ph_hi; };
struct Frame {
    LAS unsigned char* lds; volatile LAS unsigned* MISC; gu_t ctl;
    int tid, lane, wave, vcu, G, bx;
    guc_t ws;
};

DI int dst_row(int mode, int n) {
    if (mode == 1) { const int t = n >> 8, lc = n & 255; return t * 256 + 128 * ((lc >> 5) & 1) + 32 * (lc >> 6) + (lc & 31); }
    if (mode == 2) return (n >> 7) * 256 + (n & 127);
    if (mode == 3) return (n >> 7) * 256 + 128 + (n & 127);
    return n;
}
struct TrItem { gcf_t W; gb_t WT; gcf_t gain; int K, N, mode, item; };
DI void tr_load(const TrItem& t, float (&wv)[32], float& g0, int lane) {
    const int nblk = t.N / 32, kb = t.item / nblk, nb = t.item % nblk, k0 = 64 * kb, n0 = 32 * nb;
#pragma unroll
    for (int i = 0; i < 32; ++i) { const int kk = 2 * i + (lane >> 5); wv[i] = __builtin_nontemporal_load(&t.W[(size_t)(k0 + kk) * t.N + n0 + (lane & 31)]); }
    { gcf_t gp = t.gain ? t.gain : t.W; g0 = gp[k0 + lane]; }
}
DI void tr_store(const TrItem& t, const float (&wv)[32], float g0, LAS float* scr, int lane) {
    const int nblk = t.N / 32, kb = t.item / nblk, nb = t.item % nblk, k0 = 64 * kb, n0 = 32 * nb;
    const float g1 = t.gain ? g0 : 1.f;
#pragma unroll
    for (int i = 0; i < 32; ++i) { const int kk = 2 * i + (lane >> 5); const float gk = __builtin_bit_cast(float, __builtin_amdgcn_ds_bpermute(kk * 4, __builtin_bit_cast(int, g1))); scr[kk * 33 + (lane & 31)] = wv[i] * gk; }
    asm volatile("s_waitcnt lgkmcnt(0)" ::: "memory");
    const int c = lane & 7;
#pragma unroll
    for (int j = 0; j < 4; ++j) { const int n = (lane >> 3) + 8 * j; const LAS float* sp = scr + (8 * c) * 33 + n;
        u32x4 o; o.x = cvtpk(sp[0 * 33], sp[1 * 33]); o.y = cvtpk(sp[2 * 33], sp[3 * 33]); o.z = cvtpk(sp[4 * 33], sp[5 * 33]); o.w = cvtpk(sp[6 * 33], sp[7 * 33]);
        __builtin_nontemporal_store(o, (GAS u32x4*)(t.WT + (size_t)dst_row(t.mode, n0 + n) * t.K + k0 + 8 * c)); }
    asm volatile("s_waitcnt lgkmcnt(0)" ::: "memory");
}
DI TrItem conv_decode(const Frame& F, const Args& a, int L, int it) {
    const int j = L >> 1; const bool is_na = !(L & 1);
    constexpr int I_QKV = 16 * 96, I_O = 16 * 32, I_G = 16 * 256;
    TrItem t; int r = it;
    if (r < I_QKV) { t.W = (gcf_t)a.in[is_na ? 3 : 8] + (size_t)j * 1024 * 3072; t.WT = (gb_t)(F.ws + WS_WQKVP); t.gain = (gcf_t)a.in[1] + L * 1024; t.K = 1024; t.N = 3072; t.mode = 1; t.item = r; return t; } r -= I_QKV;
    if (r < I_O) { t.W = (gcf_t)a.in[is_na ? 4 : 9] + (size_t)j * 1024 * 1024; t.WT = (gb_t)(F.ws + WS_WO); t.gain = (gcf_t)nullptr; t.K = 1024; t.N = 1024; t.mode = 0; t.item = r; return t; } r -= I_O;
    if (r < 2 * I_G) { const int up = r >= I_G; r -= up * I_G; const int e = r >> 8;
        t.W = (gcf_t)a.in[22 + up] + (size_t)L * 16 * 1024 * 512 + (size_t)e * 1024 * 512; t.WT = (gb_t)(F.ws + WS_WGU) + (size_t)e * 1024 * 1024; t.gain = (gcf_t)a.in[2] + L * 1024; t.K = 1024; t.N = 512; t.mode = 2 + up; t.item = r & 255; return t; }
    r -= 2 * I_G;
    { const int e = r >> 8; t.W = (gcf_t)a.in[24] + (size_t)L * 16 * 512 * 1024 + (size_t)e * 512 * 1024; t.WT = (gb_t)(F.ws + WS_WD) + (size_t)e * 1024 * 512; t.gain = (gcf_t)nullptr; t.K = 512; t.N = 1024; t.mode = 0; t.item = r & 255; return t; }
}
DI void convert_layer(const Frame& F, const Args& a, int L) {
    LAS float* scr = (LAS float*)(F.lds + F.wave * 16384);
    const int gw = F.vcu * NWAVES + F.wave, NGW = F.G * NWAVES;
    constexpr int NITEMS = 16 * 96 + 16 * 32 + 3 * 16 * 256;
    int it = gw; if (it >= NITEMS) return;
    TrItem ta = conv_decode(F, a, L, it), tb = ta; float va[32], vb[32], ga, gb;
    tr_load(ta, va, ga, F.lane);
    for (;;) {
        const bool hb = it + NGW < NITEMS;
        if (hb) { tb = conv_decode(F, a, L, it + NGW); tr_load(tb, vb, gb, F.lane); }
        tr_store(ta, va, ga, scr, F.lane);
        if (!hb) break;
        it += NGW;
        const bool ha = it + NGW < NITEMS;
        if (ha) { ta = conv_decode(F, a, L, it + NGW); tr_load(ta, va, ga, F.lane); }
        tr_store(tb, vb, gb, scr, F.lane);
        if (!ha) break;
        it += NGW;
    }
}
DI void stream_load(gcf_t xrow, f32x4 (&v)[4], int lane) {
    const GAS f32x4* xr = (const GAS f32x4*)xrow + lane;
#pragma unroll
    for (int j = 0; j < 4; ++j) v[j] = xr[64 * j];
}
DI void stream_store(const f32x4 (&v)[4], gb_t orow, gf_t rs, int lane) {
    float s = 0.f;
#pragma unroll
    for (int j = 0; j < 4; ++j) s += (v[j].x * v[j].x + v[j].y * v[j].y) + (v[j].z * v[j].z + v[j].w * v[j].w);
    const float r = rsqrtf(wave_sum(s) * (1.f / D) + RMS_EPS);
    GAS u32x2* o = (GAS u32x2*)orow + lane;
#pragma unroll
    for (int j = 0; j < 4; ++j) { u32x2 w; w.x = cvtpk(v[j].x, v[j].y); w.y = cvtpk(v[j].z, v[j].w); o[64 * j] = w; }
    if (lane == 0) *rs = r;
}

DI void glds16(const GAS void* gsrc, unsigned lds_dst) { unsigned keep;
    asm volatile("s_mov_b32 %0, m0\n\ts_mov_b32 m0, %2\n\ts_nop 0\n\tglobal_load_lds_dwordx4 %1, off\n\ts_mov_b32 m0, %0" : "=&s"(keep) : "v"(gsrc), "s"(lds_dst) : "memory"); }
#define ATT_WAIT_BAR() asm volatile("s_waitcnt vmcnt(0) lgkmcnt(0)\n\ts_barrier" ::: "memory")
DI int crow(int r, int hi) { return (r & 3) + 8 * (r >> 2) + 4 * hi; }
DI s16x4 vtr(const LAS char* p) { return __builtin_bit_cast(s16x4, __builtin_amdgcn_ds_read_tr16_b64_v4i16((LAS s16x4*)p)); }
DI bf16x8 pack8(const f32x16& x, int s) {
    u32x4 p; p.x = cvtpk(x[8 * s], x[8 * s + 1]); p.y = cvtpk(x[8 * s + 2], x[8 * s + 3]); p.z = cvtpk(x[8 * s + 4], x[8 * s + 5]); p.w = cvtpk(x[8 * s + 6], x[8 * s + 7]);
    return __builtin_bit_cast(bf16x8, p);
}
#define MFMA32(a, b, c) __builtin_amdgcn_mfma_f32_32x32x16_bf16((a), (b), (c), 0, 0, 0)

DI void glds16s(const GAS void* sbase, unsigned voff, unsigned lds_dst) { unsigned keep;
    asm volatile("s_mov_b32 %0, m0\n\ts_mov_b32 m0, %3\n\ts_nop 0\n\tglobal_load_lds_dwordx4 %1, %2\n\ts_mov_b32 m0, %0" : "=&s"(keep) : "v"(voff), "s"(sbase), "s"(lds_dst) : "memory"); }
DI void glds16s_pair(const GAS void* sbase, unsigned voff, unsigned dst0, unsigned dst1m) { unsigned keep;
    asm volatile("s_mov_b32 %0, m0\n\ts_mov_b32 m0, %3\n\ts_nop 0\n\tglobal_load_lds_dwordx4 %1, %2\n\ts_mov_b32 m0, %4\n\ts_nop 0\n\tglobal_load_lds_dwordx4 %1, %2 offset:128\n\ts_mov_b32 m0, %0"
                 : "=&s"(keep) : "v"(voff), "s"(sbase), "s"(dst0), "s"(dst1m) : "memory"); }
DI void glds16s_kv(const GAS void* sbase, unsigned voffk, unsigned voffv, unsigned dstk, unsigned dstvm) { unsigned keep;
    asm volatile("s_mov_b32 %0, m0\n\ts_mov_b32 m0, %3\n\ts_nop 0\n\tglobal_load_lds_dwordx4 %1, %2\n\ts_mov_b32 m0, %4\n\ts_nop 0\n\tglobal_load_lds_dwordx4 %5, %2 offset:2048\n\ts_mov_b32 m0, %0"
                 : "=&s"(keep) : "v"(voffk), "s"(sbase), "s"(dstk), "s"(dstvm), "v"(voffv) : "memory"); }
DI void na_wait_bar(int n) {
    if (n >= 12) asm volatile("s_waitcnt vmcnt(12) lgkmcnt(0)\n\ts_barrier" ::: "memory");
    else if (n >= 8) asm volatile("s_waitcnt vmcnt(8) lgkmcnt(0)\n\ts_barrier" ::: "memory");
    else if (n >= 4) asm volatile("s_waitcnt vmcnt(4) lgkmcnt(0)\n\ts_barrier" ::: "memory");
    else if (n >= 2) asm volatile("s_waitcnt vmcnt(2) lgkmcnt(0)\n\ts_barrier" ::: "memory");
    else asm volatile("s_waitcnt vmcnt(0) lgkmcnt(0)\n\ts_barrier" ::: "memory");
}
DI void na_phase(const Frame& F, gcb_t QKV, gcf_t rpb, gcf_t qg, gcf_t kg, gb_t AO) {
    const int w = F.wave;
    LAS char* const L0 = (LAS char*)F.lds;
    LAS float* const TBL = (LAS float*)(L0 + 65536);
    LAS float* const wsc = (LAS float*)(L0 + 67584) + w * 64;
    const unsigned lds0 = (unsigned)(uintptr_t)L0;
    const float shift = uni(8.f * wave_max(fabsf(qg[F.lane])) * wave_max(fabsf(kg[F.lane])));
    const float c1 = 0.125f * LOG2E;
    constexpr int NU = BATCH * 16 * 16;
    ATT_WAIT_BAR();
    if (F.vcu >= NU) { ATT_WAIT_BAR(); return; }
    int wl = w; asm volatile("" : "+s"(wl));
    const int lane = fresh_lane(), r32 = lane & 31, hi = lane >> 5, tid = wl * 64 + lane;
    const int c0 = 16 * (wl & 3), c = c0 + (r32 & 15);
    int kstart = c0 - 8; kstart = kstart < 0 ? 0 : (kstart > 32 ? 32 : kstart);
    int cs = c - 8; cs = cs < 0 ? 0 : (cs > 48 ? 48 : cs);
    const int dl = kstart + 4 * hi - cs;
    const unsigned kvo = (unsigned)lane * 6144u + (unsigned)wl * 16u;
    const unsigned vvo = (unsigned)(16 * (wl & 3) + (lane >> 2)) * 6144u + (unsigned)(wl >> 2) * 64u + (unsigned)(lane & 3) * 16u;
    const unsigned kdst = lds0 + wl * 1024;
    int va[4];
#pragma unroll
    for (int j = 0; j < 4; ++j) { const int row = kstart + 4 * hi + ((lane & 15) >> 2) + 8 * j; va[j] = (row >> 4) * 1024 + (row & 15) * 64 + ((lane >> 4) & 1) * 32 + (lane & 3) * 8; }
#define NA_GEOM(u_, b_, h_, R0_, klo_, khi_) const int b_ = (u_) >> 8, h_ = ((u_) >> 4) & 15, R0_ = 4 * ((u_) & 15); \
        int klo_ = R0_ - 4; klo_ = klo_ < 0 ? 0 : klo_; int khi_ = R0_ + 3 - 4; khi_ = (khi_ < 0 ? 0 : (khi_ > 56 ? 56 : khi_)) + 7
#define NA_KBASE(b_, h_) (QKV + (size_t)(b_) * SEQ * 3072 + 1024 + (h_) * 64)
#define NA_DMA(kb_, kr_, gs_) do { const unsigned d_ = (unsigned)__builtin_amdgcn_readfirstlane(kdst + (unsigned)(((gs_) & 3) * 16384)); const unsigned long long p_ = (unsigned long long)((kb_) + (size_t)(kr_) * 64 * 3072); \
        const unsigned plo_ = (unsigned)__builtin_amdgcn_readfirstlane((int)(unsigned)p_), phi_ = (unsigned)__builtin_amdgcn_readfirstlane((int)(unsigned)(p_ >> 32)); \
        glds16s_kv((const GAS void*)(((unsigned long long)phi_ << 32) | plo_), kvo, vvo, d_, d_ + (8192u - 2048u)); } while (0)
#define NA_LOADQ(dst, b_, h_, R0_) do { const int r_ = (R0_) + 2 * (wl >> 2) + (r32 >> 4); gcb_t qp = QKV + ((size_t)(b_) * SEQ + r_ * 64 + c) * 3072 + (h_) * 64 + hi * 8; \
        _Pragma("unroll") for (int d0 = 0; d0 < 4; ++d0) dst[d0] = *(const GAS bf16x8*)(qp + d0 * 16); } while (0)
    int u = F.vcu, gst = 0, h_tbl = -1; bool first = true;
    bf16x8 qf[4], qn[4];
    { NA_GEOM(u, b0_, h0_, R00_, kl0_, kh0_); (void)kh0_;
      for (int idx = tid; idx < 15 * 31; idx += NTHREADS) TBL[idx] = (rpb[h0_ * 465 + idx] - shift) * LOG2E;
      h_tbl = h0_;
      NA_LOADQ(qf, b0_, h0_, R00_);
      asm volatile("" : "+v"(qf[0]), "+v"(qf[1]), "+v"(qf[2]), "+v"(qf[3]));
      gcb_t kb0 = NA_KBASE(b0_, h0_);
      NA_DMA(kb0, kl0_, 0); NA_DMA(kb0, kl0_ + 1, 1); NA_DMA(kb0, kl0_ + 2, 2); }
    for (;;) {
        NA_GEOM(u, b, h, R0, kr_lo, kr_hi);
        const int un = u + F.G; const bool has_next = un < NU;
        NA_GEOM(has_next ? un : u, bn, hn, R0n, kn_lo, kn_hi); (void)kn_hi;
        gcb_t kbase = NA_KBASE(b, h); gcb_t kbasen = NA_KBASE(bn, hn);
        const int r0 = R0 + 2 * (wl >> 2);
        int wlo = r0 - 4; wlo = wlo < 0 ? 0 : (wlo > 56 ? 56 : wlo); int whi = r0 + 1 - 4; whi = (whi < 0 ? 0 : (whi > 56 ? 56 : whi)) + 7;
        const int r = r0 + (r32 >> 4);
        int rs = r - 4; rs = rs < 0 ? 0 : (rs > 56 ? 56 : rs);
        const LAS char* const tb0 = (const LAS char*)TBL + ((7 - r) * 31 + 15 - c + kstart + 4 * hi) * 4;
        const int nst = first ? 0 : 4;
        float l = 0.f; f32x16 o0 = {}, o1 = {};
        for (int kr = kr_lo; kr <= kr_hi; ++kr, ++gst) {
            const int st = kr - kr_lo, slot = (gst & 3) * 16384, rem = kr_hi - kr;
            int allow = 4;
            if (st == 0) allow = 4 + nst; else if (st == 1 || st == 2) allow = 4 + nst; else if (st == 5 || st == 6) allow = has_next ? 8 : 4;
            if (!has_next) { if (rem == 1) allow = 2; else if (rem == 0) allow = 0; }
            na_wait_bar(allow);
            if (st == 4 && has_next) {
                const int r_ = R0n + 2 * (wl >> 2) + (r32 >> 4); gcb_t qp = QKV + ((size_t)bn * SEQ + r_ * 64 + c) * 3072 + hn * 64 + hi * 8;
                asm volatile("global_load_dwordx4 %0, %4, off\n\tglobal_load_dwordx4 %1, %4, off offset:32\n\tglobal_load_dwordx4 %2, %4, off offset:64\n\tglobal_load_dwordx4 %3, %4, off offset:96"
                             : "=&v"(qn[0]), "=&v"(qn[1]), "=&v"(qn[2]), "=&v"(qn[3]) : "v"(qp) : "memory"); }
            if (rem >= 3) NA_DMA(kbase, kr + 3, gst + 3); else if (has_next) NA_DMA(kbasen, kn_lo + (2 - rem), gst + 3);
            if (kr >= wlo && kr <= whi) {
                const LAS char* Kb = L0 + slot + hi * 1024 + (kstart + r32) * 16; const LAS char* Vb = L0 + slot + 8192;
                const LAS char* tb = tb0 + kr * 124;
                bf16x8 kf[4];
#pragma unroll
                for (int d0 = 0; d0 < 4; ++d0) kf[d0] = *(const LAS bf16x8*)(Kb + d0 * 2048);
                float tv[16];
#pragma unroll
                for (int i = 0; i < 16; ++i) tv[i] = *(const LAS float*)(tb + ((i & 3) + 8 * (i >> 2)) * 4);
                s16x4 vl[8];
#pragma unroll
                for (int j = 0; j < 4; ++j) { vl[2 * j] = vtr(Vb + va[j]); vl[2 * j + 1] = vtr(Vb + 4096 + va[j]); }
                __builtin_amdgcn_sched_barrier(0);
                f32x16 s0 = {};
#pragma unroll
                for (int d0 = 0; d0 < 4; ++d0) s0 = MFMA32(kf[d0], qf[d0], s0);
                __builtin_amdgcn_sched_barrier(0);
                asm volatile("" : "+v"(tv[0]), "+v"(tv[1]), "+v"(tv[2]), "+v"(tv[3]), "+v"(tv[4]), "+v"(tv[5]), "+v"(tv[6]), "+v"(tv[7]));
                asm volatile("" : "+v"(tv[8]), "+v"(tv[9]), "+v"(tv[10]), "+v"(tv[11]), "+v"(tv[12]), "+v"(tv[13]), "+v"(tv[14]), "+v"(tv[15]));
                const bool rowok = (unsigned)(kr - rs) < 8u;
                float ls = 0.f;
#pragma unroll
                for (int i = 0; i < 16; ++i) { const int ko = (i & 3) + 8 * (i >> 2);
                    const bool ok = rowok && ((unsigned)(dl + ko) < 16u); float p = __builtin_amdgcn_exp2f(s0[i] * c1 + tv[i]); asm volatile("" : "+v"(p)); p = ok ? p : 0.f; s0[i] = p; ls += p; }
                l += ls;
                const bf16x8 pa0 = pack8(s0, 0), pa1 = pack8(s0, 1);
                o0 = MFMA32(pa0, __builtin_shufflevector(vl[0], vl[2], 0, 1, 2, 3, 4, 5, 6, 7), o0);
                o1 = MFMA32(pa0, __builtin_shufflevector(vl[1], vl[3], 0, 1, 2, 3, 4, 5, 6, 7), o1);
                o0 = MFMA32(pa1, __builtin_shufflevector(vl[4], vl[6], 0, 1, 2, 3, 4, 5, 6, 7), o0);
                o1 = MFMA32(pa1, __builtin_shufflevector(vl[5], vl[7], 0, 1, 2, 3, 4, 5, 6, 7), o1);
            }
        }
        wsc[hi * 32 + r32] = l;
        asm volatile("s_waitcnt lgkmcnt(0)" ::: "memory");
        LAS unsigned short* stg = (LAS unsigned short*)(L0 + 69632 + w * 4096) + hi * 4 * 64 + r32;
#pragma unroll
        for (int i = 0; i < 16; ++i) { const int q = crow(i, hi); const float rl = __builtin_amdgcn_rcpf(wsc[q] + wsc[32 + q]);
            stg[((i & 3) + 8 * (i >> 2)) * 64] = (unsigned short)(cvtpk(o0[i] * rl, 0.f) & 0xffffu); stg[((i & 3) + 8 * (i >> 2)) * 64 + 32] = (unsigned short)(cvtpk(o1[i] * rl, 0.f) & 0xffffu); }
        asm volatile("s_waitcnt lgkmcnt(0)" ::: "memory");
        { gcc_t ob_ = (gcc_t)(AO + ((size_t)b * SEQ + r0 * 64 + c0) * 1024 + h * 64);
          const LAS char* sp = L0 + 69632 + w * 4096 + lane * 16;
#pragma unroll
          for (int jj = 0; jj < 4; ++jj) { const u32x4 val = *(const LAS u32x4*)(sp + jj * 1024);
              const unsigned vo = (unsigned)((jj >> 1) * 64 + 8 * (jj & 1) + (lane >> 3)) * 2048u + (unsigned)(lane & 7) * 16u;
              *(GAS u32x4*)(ob_ + vo) = val; } }
        if (!has_next) break;
        if (hn != h_tbl) {
            ATT_WAIT_BAR();
            for (int idx = tid; idx < 15 * 31; idx += NTHREADS) TBL[idx] = (rpb[hn * 465 + idx] - shift) * LOG2E;
            h_tbl = hn; ATT_WAIT_BAR(); }
#pragma unroll
        for (int d0 = 0; d0 < 4; ++d0) qf[d0] = qn[d0];
        u = un; first = false;
    }
#undef NA_GEOM
#undef NA_KBASE
#undef NA_DMA
#undef NA_LOADQ
    ATT_WAIT_BAR();
}

DI int t5_bucket(int rel) { const int n = rel < 0 ? -rel : rel; int bk;
    if (n < 8) bk = n; else bk = 8 + (n >= 12) + (n >= 16) + (n >= 23) + (n >= 32) + (n >= 46) + (n >= 64) + (n >= 91);
    return bk + (rel > 0 ? 16 : 0); }
DI void diff_epilogue(const f32x16 (&oa)[4], const f32x16 (&ob)[4], LAS float* wsc, float lam, float oml, gcf_t subg, LAS char* L0, int w, gb_t AO, size_t tokb, int qw0, int h) {
    const int lane = fresh_lane(), r32 = lane & 31, hi = lane >> 5;
        float sg[4];
#pragma unroll
        for (int db = 0; db < 4; ++db) sg[db] = subg[db * 32 + r32];
        asm volatile("" : "+v"(sg[0]), "+v"(sg[1]), "+v"(sg[2]), "+v"(sg[3]));
#pragma unroll
        for (int db = 0; db < 4; ++db) sg[db] *= oml;
        LAS unsigned short* stg = (LAS unsigned short*)(L0 + w * 8192) + hi * 4 * 128 + r32;
#pragma unroll
        for (int i = 0; i < 16; ++i) { const int qq = crow(i, hi); const float ra = __builtin_amdgcn_rcpf(wsc[qq] + wsc[32 + qq]), rbb = lam * __builtin_amdgcn_rcpf(wsc[64 + qq] + wsc[96 + qq]);
            float v[4]; float ss = 0.f;
#pragma unroll
            for (int db = 0; db < 4; ++db) { v[db] = oa[db][i] * ra - ob[db][i] * rbb; ss += v[db] * v[db]; }
            ss += SWZ_XOR(ss, 1); ss += SWZ_XOR(ss, 2); ss += SWZ_XOR(ss, 4); ss += SWZ_XOR(ss, 8); ss += SWZ_XOR(ss, 16);
            const float rn = rsqrtf(ss * (1.f / 128.f) + RMS_EPS);
#pragma unroll
            for (int db = 0; db < 4; ++db) stg[((i & 3) + 8 * (i >> 2)) * 128 + db * 32] = (unsigned short)(cvtpk(v[db] * rn * sg[db], 0.f) & 0xffffu);
            __builtin_amdgcn_sched_barrier(0); }
        asm volatile("s_waitcnt lgkmcnt(0)" ::: "memory");
        { gcc_t ob_ = (gcc_t)(AO + (tokb + qw0) * 1024 + h * 128);
          const unsigned vo = (unsigned)(lane >> 4) * 2048u + (unsigned)(lane & 15) * 16u;
          const LAS char* sp = L0 + w * 8192 + lane * 16;
#pragma unroll
          for (int jj = 0; jj < 8; ++jj) { const u32x4 val = *(const LAS u32x4*)(sp + jj * 1024); *(GAS u32x4*)(ob_ + (size_t)jj * 8192 + vo) = val; } }
}
DI void diff_phase(const Frame& F, gcb_t QKV, guc_t Q8, guc_t K8, gcf_t rel_bias, gcf_t qg, gcf_t kg, gcf_t lq1, gcf_t lk1, gcf_t lq2, gcf_t lk2,
                   gcf_t subg, float lambda_init, gb_t AO) {
    const int w = F.wave;
    LAS char* const L0 = (LAS char*)F.lds;
    LAS float* const TBL = (LAS float*)(L0 + ROWS_OFF);
    LAS float* const wsc = (LAS float*)(L0 + ROWS_OFF + 2048) + w * 128;
    const unsigned lds0 = (unsigned)(uintptr_t)L0;
    float shift, lam;
    { const int lane = F.lane;
    float mb = fmaxf(fmaxf(fabsf(rel_bias[lane]), fabsf(rel_bias[64 + lane])), fmaxf(fabsf(rel_bias[128 + lane]), fabsf(rel_bias[192 + lane])));
    shift = uni(8.f * wave_max(fabsf(qg[lane])) * wave_max(fabsf(kg[lane])) + wave_max(mb));
    lam = uni(__expf(wave_sum(lq1[lane] * lk1[lane])) - __expf(wave_sum(lq2[lane] * lk2[lane])) + lambda_init); }
    const float c1 = 0.125f * LOG2E, oml = uni(1.f - lambda_init);
    for (int it = 0;; ++it) {
        const int u = it * F.G + F.vcu; if (u >= BATCH * 8 * 16) break;
        const int b = u >> 7, h = (u >> 4) & 7, qb = u & 15;
        const int lane = fresh_lane(), r32 = lane & 31, hi = lane >> 5, tid = w * 64 + lane;
        const unsigned kvo = (unsigned)(8 * w + (lane >> 3)) * 1024u + (unsigned)(((lane & 7) ^ (((lane >> 4) & 3) | ((w & 1) << 2))) * 16);
        const int kg_ = ((r32 >> 1) & 3) | (((r32 >> 3) & 1) << 2), kxo = (hi * 2) ^ kg_;
        const int ko0 = (r32 >> 3) * 1024 + (r32 & 7) * 128 + (kxo << 4), ko1 = (r32 >> 3) * 1024 + (r32 & 7) * 128 + ((kxo ^ 1) << 4);
        const unsigned vvo = (unsigned)(16 * (w & 3) + (lane >> 2)) * 6144u + (unsigned)(w >> 2) * 64u + (unsigned)(lane & 3) * 16u;
        const unsigned kdst = lds0 + w * 1024, vdst = lds0 + 32768 + w * 1024;
        const size_t tokb = (size_t)b * SEQ; const int qw0 = qb * 256 + 32 * w, q = qw0 + r32;
        ATT_WAIT_BAR();
        TBL[tid] = (rel_bias[t5_bucket(tid - 256) * 8 + h] - shift) * LOG2E;
        const float cbp = uni((rel_bias[31 * 8 + h] - shift) * LOG2E), cbn = uni((rel_bias[15 * 8 + h] - shift) * LOG2E);
        guc_t kbase = K8 + tokb * 1024 + h * 128;
        gcb_t vbase = QKV + tokb * 3072 + 2048 + h * 128;
#define DIFF_DMA_K(t, ks_) do { kptr += 64 * 1024; glds16s(kptr, kvo, (unsigned)__builtin_amdgcn_readfirstlane(kdst + (ks_))); } while (0)
#define DIFF_DMA_V(t, vs_) do { vptr += 64 * 3072; const unsigned d_ = (unsigned)__builtin_amdgcn_readfirstlane(vdst + (vs_)); glds16s_pair(vptr, vvo, d_, d_ + (8192u - 128u)); } while (0)
        guc_t kptr = kbase - 64 * 1024; gcb_t vptr = vbase - 64 * 3072;
        DIFF_DMA_K(0, 0); DIFF_DMA_V(0, 0);
        v8i32 qa8[2];
        { const GAS u32x4* qp = (const GAS u32x4*)(Q8 + (tokb + q) * 1024 + h * 128 + hi * 32);
#pragma unroll
          for (int cc = 0; cc < 2; ++cc) { const u32x4 x0 = qp[cc * 4], x1 = qp[cc * 4 + 1];
              qa8[cc] = (v8i32){(int)x0.x, (int)x0.y, (int)x0.z, (int)x0.w, (int)x1.x, (int)x1.y, (int)x1.z, (int)x1.w}; }
          asm volatile("" : "+v"(qa8[0]), "+v"(qa8[1])); }
        float l0 = 0.f, l1 = 0.f; f32x16 oa[4] = {}, ob[4] = {};
        const int vlane = (4 * hi + ((lane & 15) >> 2)) * 64 + ((lane >> 4) & 1) * 32 + (lane & 3) * 8;
        int vs_cur = 0, vs_prev = 0;
#define SB_ __builtin_amdgcn_sched_barrier(0)
#define LDK8(c, b_, hf) (*(const LAS u32x4*)(Kb + (hf) * 4096 + (((b_) ? ko1 : ko0) ^ ((c) * 64))))
#define LDV(VB, j, db, ks) do { vlo[j] = vtr((VB) + (db) * 4096 + (ks) * 1024); vhi[j] = vtr((VB) + (db) * 4096 + (ks) * 1024 + 512); } while (0)
#define EL_B(LS, e, B) do { const float p_ = __builtin_amdgcn_exp2f(sc[e] * c1 + (B)); sc[e] = p_; LS += p_; } while (0)
#define NEAR_B(R, e, KOFF) (TBL[(R) + ((KOFF) + ((e) & 3) + 8 * ((e) >> 2))])
#define MIXSTEP(VB, KS0, i, OACC, LS, NEAR, KOFF, PF, NC, NHF) do { if ((i) + 2 < 8) LDV(VB, (i) + 2, ((i) + 2) >> 1, (KS0) + (((i) + 2) & 1)); \
            if (PF) { if ((i) == 0) kn0 = LDK8(NC, 0, NHF); else if ((i) == 1) kn1 = LDK8(NC, 1, NHF); } \
            { const bf16x8 vf = __builtin_shufflevector(vlo[i], vhi[i], 0, 1, 2, 3, 4, 5, 6, 7); OACC[(i) >> 1] = MFMA32(((i) & 1) ? pp1 : pp0, vf, OACC[(i) >> 1]); } \
            { float x0_ = sc[2 * (i)], x1_ = sc[2 * (i) + 1]; \
              if (NEAR) { const int l_ = fresh_lane(); const int r_ = 4 * (l_ >> 5) - (l_ & 31) + (rbt - qw0); \
                  x0_ += NEAR_B(r_, 2 * (i), KOFF); x1_ += NEAR_B(r_, 2 * (i) + 1, KOFF); } \
              asm volatile("v_exp_f32 %0, %0\n\tv_exp_f32 %1, %1\n\tv_add_f32 %2, %2, %0\n\tv_add_f32 %2, %2, %1" : "+v"(x0_), "+v"(x1_), "+v"(LS)); \
              sc[2 * (i)] = x0_; sc[2 * (i) + 1] = x1_; } \
            SB_; } while (0)
#define HALFROUND(C, NEAR, HF, VB, KS0, OPREV, LS, PF, NC, NHF) do { \
            f32x16 sc = {}; \
            LDV(VB, 0, 0, (KS0)); LDV(VB, 1, 0, (KS0) + 1); \
            { const v8i32 ka8 = (v8i32){(int)kn0.x, (int)kn0.y, (int)kn0.z, (int)kn0.w, (int)kn1.x, (int)kn1.y, (int)kn1.z, (int)kn1.w}; \
              sc = __builtin_amdgcn_mfma_scale_f32_32x32x64_f8f6f4(ka8, qa8[C], sc, 0, 0, 0, 0, 0, 0); } \
            SB_; \
            MIXSTEP(VB, KS0, 0, OPREV, LS, NEAR, 32 * (HF), PF, NC, NHF); MIXSTEP(VB, KS0, 1, OPREV, LS, NEAR, 32 * (HF), PF, NC, NHF); MIXSTEP(VB, KS0, 2, OPREV, LS, NEAR, 32 * (HF), PF, NC, NHF); MIXSTEP(VB, KS0, 3, OPREV, LS, NEAR, 32 * (HF), PF, NC, NHF); \
            MIXSTEP(VB, KS0, 4, OPREV, LS, NEAR, 32 * (HF), PF, NC, NHF); MIXSTEP(VB, KS0, 5, OPREV, LS, NEAR, 32 * (HF), PF, NC, NHF); MIXSTEP(VB, KS0, 6, OPREV, LS, NEAR, 32 * (HF), PF, NC, NHF); MIXSTEP(VB, KS0, 7, OPREV, LS, NEAR, 32 * (HF), PF, NC, NHF); \
            pp0 = pack8(sc, 0); pp1 = pack8(sc, 1); \
            SB_; } while (0)
#define TILE(NEAR) do { \
            HALFROUND(0, NEAR, 0, Vp, 2, ob, l0, 1, 0, 1); \
            if (t < 63) DIFF_DMA_K(t + 1, 8192 - kslot); \
            HALFROUND(0, NEAR, 1, Vb, 0, oa, l0, 1, 1, 0); \
            if (t < 63) DIFF_DMA_V(t + 1, vsn_); \
            HALFROUND(1, NEAR, 0, Vb, 2, oa, l1, 1, 1, 1); \
            HALFROUND(1, NEAR, 1, Vb, 0, ob, l1, 0, 0, 0); } while (0)
        bf16x8 pp0 = {}, pp1 = {};
        s16x4 vlo[8], vhi[8];
        int tn0 = (qw0 - 154) >> 6; tn0 = tn0 < -1 ? 0 : tn0 + 1; int tn1 = (qw0 + 122 + 63) >> 6; tn1 = tn1 > 64 ? 64 : tn1;
#define TILE_LOOP(T0, T1, NEAR) for (int t = (T0); t < (T1); ++t) { \
            const int kslot = (t & 1) * 8192; int vsn_ = 0; \
            ATT_WAIT_BAR(); \
            { if (t > 0) { vs_prev = vs_cur; vs_cur = vs_cur + 16384; vs_cur = vs_cur >= 49152 ? 0 : vs_cur; } \
              int vs_next = vs_cur + 16384; vs_next = vs_next >= 49152 ? 0 : vs_next; vsn_ = vs_next; } \
            const LAS char* Kb = L0 + kslot; const LAS char* Vb = L0 + 32768 + vs_cur + vlane; const LAS char* Vp = L0 + 32768 + vs_prev + vlane; \
            const int rbt = 64 * t + 256; \
            u32x4 kn0 = LDK8(0, 0, 0), kn1 = LDK8(0, 1, 0); \
            SB_; \
            TILE(NEAR); }
#define PV_DRAIN() do { const LAS char* Vd_ = L0 + 32768 + vs_cur + vlane; LDV(Vd_, 0, 0, 2); LDV(Vd_, 1, 0, 3); \
            _Pragma("unroll") for (int i = 0; i < 8; ++i) { if (i + 2 < 8) LDV(Vd_, i + 2, (i + 2) >> 1, 2 + ((i + 2) & 1)); \
                const bf16x8 vf = __builtin_shufflevector(vlo[i], vhi[i], 0, 1, 2, 3, 4, 5, 6, 7); \
                ob[i >> 1] = MFMA32((i & 1) ? pp1 : pp0, vf, ob[i >> 1]); SB_; } \
            pp0 = (bf16x8){}; pp1 = (bf16x8){}; } while (0)
#define OL_SCALE(f) do { const float f_ = (f); l0 *= f_; l1 *= f_; _Pragma("unroll") for (int db = 0; db < 4; ++db) { oa[db] *= f_; ob[db] *= f_; } } while (0)
        TILE_LOOP(0, tn0, false)
        if (tn0 > 0) { PV_DRAIN(); OL_SCALE(__builtin_amdgcn_exp2f(cbn)); }
        TILE_LOOP(tn0, tn1, true)
        PV_DRAIN(); OL_SCALE(__builtin_amdgcn_exp2f(-cbp));
        TILE_LOOP(tn1, 64, false)
        if (tn1 < 64) PV_DRAIN();
#undef OL_SCALE
#undef PV_DRAIN
#undef TILE_LOOP
#undef TILE
#undef HALFROUND
#undef MIXSTEP
#undef NEAR_B
#undef EL_B
#undef LDV
#undef LDK8
#undef SB_
#undef DIFF_DMA_K
#undef DIFF_DMA_V
        { const int fl_ = fresh_lane() & 63; wsc[fl_] = l0; wsc[64 + fl_] = l1; }
        ATT_WAIT_BAR();
        diff_epilogue(oa, ob, wsc, lam, oml, subg, L0, w, AO, tokb, qw0, h);
    }
    ATT_WAIT_BAR();
}

typedef float f32x4v __attribute__((ext_vector_type(4)));
DI void router_phase(const Frame& F, gcb_t x, gcf_t g, gcf_t wg, gcf_t bg, gcf_t we, gcf_t be, gf_t rs2, TokG T, gu_t cnt) {
    const int lane = F.lane, n16 = lane & 15, kq = lane >> 4, w = F.wave;
    LAS float* const WL = (LAS float*)F.lds;
    LAS float* const scr = (LAS float*)(F.lds + 131072) + w * 512;
    __syncthreads();
    {
        f32x4 cw[2][5]; float gk[2];
#pragma unroll
        for (int rr = 0; rr < 2; ++rr) { const int k = F.tid + rr * NTHREADS; gk[rr] = g[k]; cw[rr][0] = ((const GAS f32x4*)wg)[k];
#pragma unroll
            for (int q = 0; q < 4; ++q) cw[rr][1 + q] = ((const GAS f32x4*)we)[k * 4 + q]; }
        LAS unsigned short* const WH = (LAS unsigned short*)F.lds; LAS unsigned short* const WLo = (LAS unsigned short*)(F.lds + 65536);
#pragma unroll
        for (int rr = 0; rr < 2; ++rr) { const int k = F.tid + rr * NTHREADS, Tt = k >> 5, kq_ = (k >> 3) & 3, j = k & 7;
#pragma unroll
            for (int c = 0; c < 32; ++c) { const int oh = c >> 4, n = c & 15; const int idx = (((Tt * 2 + oh) * 4 + kq_) * 16 + n) * 8 + j;
                unsigned short hb = 0, lb = 0;
                if (c < 20) { const float wv = cw[rr][c >> 2][c & 3] * gk[rr]; hb = (unsigned short)f2bf(wv); lb = (unsigned short)f2bf(wv - bf2f(hb)); }
                WH[idx] = hb; WLo[idx] = lb; } }
    }
    if (F.tid < 16) F.MISC[64 + F.tid] = 0u;
    __syncthreads();
    const LAS char* const Wb = (const LAS char*)F.lds + lane * 16;
    const int gw = F.vcu * NWAVES + F.wave, NGW = F.G * NWAVES;
    float bgv[4], bev[16];
#pragma unroll
    for (int i = 0; i < 4; ++i) bgv[i] = bg[i];
#pragma unroll
    for (int i = 0; i < 16; ++i) bev[i] = be[i];
    asm volatile("" : "+v"(bgv[0]), "+v"(bgv[1]), "+v"(bgv[2]), "+v"(bgv[3]));
    asm volatile("" : "+v"(bev[0]), "+v"(bev[1]), "+v"(bev[2]), "+v"(bev[3]), "+v"(bev[4]), "+v"(bev[5]), "+v"(bev[6]), "+v"(bev[7]));
    asm volatile("" : "+v"(bev[8]), "+v"(bev[9]), "+v"(bev[10]), "+v"(bev[11]), "+v"(bev[12]), "+v"(bev[13]), "+v"(bev[14]), "+v"(bev[15]));
    for (int task = gw; task < M / 16; task += NGW) {
        const int tok0 = task * 16;
        const GAS u32x4* xr = (const GAS u32x4*)(x + (size_t)(tok0 + n16) * D) + kq;
        f32x4v a0 = {0.f, 0.f, 0.f, 0.f}, a1 = {0.f, 0.f, 0.f, 0.f}; float ssq = 0.f;
        u32x4 rr_[32];
#pragma unroll
        for (int Tt = 0; Tt < 32; ++Tt) rr_[Tt] = xr[4 * Tt];
#pragma unroll
        for (int Tt = 0; Tt < 32; ++Tt) {
            const u32x4 r_ = rr_[Tt];
            float xv[8];
#pragma unroll
            for (int e = 0; e < 4; ++e) { xv[2 * e] = bf2f((unsigned short)(r_[e] & 0xffffu)); xv[2 * e + 1] = bf2f((unsigned short)(r_[e] >> 16)); }
#pragma unroll
            for (int e = 0; e < 8; ++e) ssq += xv[e] * xv[e];
            const bf16x8 av = __builtin_bit_cast(bf16x8, r_);
            const bf16x8 bh0 = *(const LAS bf16x8*)(Wb + (Tt * 2) * 1024), bh1 = *(const LAS bf16x8*)(Wb + (Tt * 2 + 1) * 1024);
            const bf16x8 bl0 = *(const LAS bf16x8*)(Wb + 65536 + (Tt * 2) * 1024), bl1 = *(const LAS bf16x8*)(Wb + 65536 + (Tt * 2 + 1) * 1024);
            a0 = __builtin_amdgcn_mfma_f32_16x16x32_bf16(av, bh0, a0, 0, 0, 0); a0 = __builtin_amdgcn_mfma_f32_16x16x32_bf16(av, bl0, a0, 0, 0, 0);
            a1 = __builtin_amdgcn_mfma_f32_16x16x32_bf16(av, bh1, a1, 0, 0, 0); a1 = __builtin_amdgcn_mfma_f32_16x16x32_bf16(av, bl1, a1, 0, 0, 0);
        }
#pragma unroll
        for (int r = 0; r < 4; ++r) { scr[(4 * kq + r) * 32 + n16] = a0[r]; scr[(4 * kq + r) * 32 + 16 + n16] = a1[r]; }
        asm volatile("s_waitcnt lgkmcnt(0)" ::: "memory");
        scr[n16 * 32 + 20 + kq] = ssq;
        asm volatile("s_waitcnt lgkmcnt(0)" ::: "memory");
        float rstd = 0.f;
        if (lane < 16) {
            float lg[24];
#pragma unroll
            for (int q4 = 0; q4 < 6; ++q4) { const f32x4v t4 = *(const LAS f32x4v*)(scr + lane * 32 + 4 * q4); lg[4 * q4] = t4[0]; lg[4 * q4 + 1] = t4[1]; lg[4 * q4 + 2] = t4[2]; lg[4 * q4 + 3] = t4[3]; }
            rstd = rsqrtf(((lg[20] + lg[21]) + (lg[22] + lg[23])) * (1.f / D) + RMS_EPS);
            const int tok = tok0 + lane;
            rs2[tok] = rstd;
            float gl[4]; int gi = 0; float gm = -1e30f;
#pragma unroll
            for (int i = 0; i < 4; ++i) { gl[i] = lg[i] * rstd + bgv[i]; if (gl[i] > gm) { gm = gl[i]; gi = i; } }
            float gs = 0.f;
#pragma unroll
            for (int i = 0; i < 4; ++i) gs += __expf(gl[i] - gm);
            const float gp = 1.f / gs;
            float el[4];
#pragma unroll
            for (int i = 0; i < 4; ++i) { float t = 0.f;
#pragma unroll
                for (int gq = 0; gq < 4; ++gq) t = (gq == gi) ? (lg[4 + gq * 4 + i] * rstd + bev[gq * 4 + i]) : t;
                el[i] = t; }
            int i0 = 0; float m0 = el[0];
#pragma unroll
            for (int i = 1; i < 4; ++i) if (el[i] > m0) { m0 = el[i]; i0 = i; }
            int i1 = -1; float m1 = -1e30f;
#pragma unroll
            for (int i = 0; i < 4; ++i) if (i != i0 && el[i] > m1) { m1 = el[i]; i1 = i; }
            const float e1 = __expf(m1 - m0), w0 = gp / (1.f + e1), w1 = gp * e1 / (1.f + e1);
            const int E0 = gi * 4 + i0, E1 = gi * 4 + i1;
            T.tok_e[tok * 2] = E0; T.tok_e[tok * 2 + 1] = E1; T.tok_w[tok * 2] = w0; T.tok_w[tok * 2 + 1] = w1;
            __hip_atomic_fetch_add((LAS unsigned*)&F.MISC[64 + E0], 1u, __ATOMIC_RELAXED, __HIP_MEMORY_SCOPE_WORKGROUP); __hip_atomic_fetch_add((LAS unsigned*)&F.MISC[64 + E1], 1u, __ATOMIC_RELAXED, __HIP_MEMORY_SCOPE_WORKGROUP);
        }
    }
    __syncthreads();
    { const int t2 = F.wave * 64 + fresh_lane(); if (t2 < 16) { const unsigned c = F.MISC[64 + t2]; if (c) atomicAdd((unsigned*)&cnt[t2], c); } }
}
DI void assign_phase(const Frame& F, gcu_t cnt, gu_t cur, TokG T, gi_t tile_e, gcf_t rs2, gf_t srs) {
    const int lane = F.lane;
    int pst = 0, myc = 0;
    { int acc = 0;
#pragma unroll
      for (int e = 0; e < NE; ++e) { const int c = (int)cnt[e]; if (lane == e) { pst = acc; myc = c; } acc += (c + 255) / 256 * 256; } }
    const unsigned long long ltmask = (1ull << lane) - 1ull;
    if (F.wave < 2) {
        for (int tok = (F.bx * 2 + F.wave) * 64 + lane; tok < M; tok += F.G * 128) {
            const int e0 = T.tok_e[tok * 2], e1 = T.tok_e[tok * 2 + 1]; int r0 = 0, r1 = 0, tot = 0;
#pragma unroll
            for (int ee = 0; ee < NE; ++ee) {
                const unsigned long long m0 = __ballot(e0 == ee), m1 = __ballot(e1 == ee);
                const int n0 = __popcll(m0), n1 = __popcll(m1);
                if (e0 == ee) r0 = __popcll(m0 & ltmask);
                if (e1 == ee) r1 = n0 + __popcll(m1 & ltmask);
                if (lane == ee) tot = n0 + n1;
            }
            int base = pst;
            if (lane < NE && tot > 0) base += (int)atomicAdd((unsigned*)&cur[lane], (unsigned)tot);
            const int s0 = __shfl(base, e0) + r0, s1 = __shfl(base, e1) + r1;
            T.slot_tok[s0] = tok; T.slot_tok[s1] = tok; T.tok_slot[tok * 2] = s0; T.tok_slot[tok * 2 + 1] = s1;
            { const float rv = rs2[tok]; srs[s0] = rv; srs[s1] = rv; }
        }
    }
    if (F.bx == F.G - 1 && F.wave >= 2) {
        for (int e = 0; e < NE; ++e) { const int ps = __shfl(pst, e), pc = __shfl(myc, e); const int padded = (pc + 255) / 256 * 256;
            for (int j2 = pc + (F.tid - 128); j2 < padded; j2 += NTHREADS - 128) { T.slot_tok[ps + j2] = 0; srs[ps + j2] = 0.f; }
            for (int tI = ps / 256 + (F.tid - 128); tI < (ps + padded) / 256; tI += NTHREADS - 128) tile_e[tI] = e; }
        { const int pe = __shfl(pst, NE - 1), ce = __shfl(myc, NE - 1); for (int tI = (pe + (ce + 255) / 256 * 256) / 256 + (F.tid - 128); tI < MAXT + 1; tI += NTHREADS - 128) tile_e[tI] = -1; }
    }
}
DI int moe_setup(const Frame& F, gcu_t cnt, gci_t slot_tok, bool gather) {
    __syncthreads();
    if (F.tid < 64) {
        const int ln = F.tid; int v = ln < NE ? ((int)cnt[ln & (NE - 1)] + 255) / 256 : 0;
#pragma unroll
        for (int d = 1; d < NE; d <<= 1) { const int t = __shfl_up(v, d); if (ln >= d) v += t; }
        if (ln < NE) F.MISC[16 + ln] = (unsigned)v;
        if (ln == NE - 1) F.MISC[32] = (unsigned)v; }
    __syncthreads();
    const int ntiles = (int)F.MISC[32];
    if (gather) { LAS int* rows = (LAS int*)(F.lds + ROWS_OFF);
        int rv[6];
#pragma unroll
        for (int i = 0; i < 6; ++i) { const int L = i * F.G + F.vcu; const int rt = L >> 2; rv[i] = (L < ntiles * 4 && F.tid < 256) ? slot_tok[rt * 256 + F.tid] : 0; }
        asm volatile("" : "+v"(rv[0]), "+v"(rv[1]), "+v"(rv[2]), "+v"(rv[3]), "+v"(rv[4]), "+v"(rv[5]));
#pragma unroll
        for (int i = 0; i < 6; ++i) { const int L = i * F.G + F.vcu; if (L < ntiles * 4 && F.tid < 256) rows[i * 256 + F.tid] = rv[i]; }
        __syncthreads(); }
    return ntiles;
}
DI void combine_phase(const Frame& F, gb_t x, gf_t out32, gcb_t Y, TokG T, gf_t rs1) {
    const int lane = F.lane, gw = F.vcu * NWAVES + F.wave, NGW = F.G * NWAVES;
    static_assert(M % (NWAVES * 256) == 0, "tokens per wave");
    const int ntk = M / NGW;
    int sl0 = 0, sl1 = 0; float ww0 = 0.f, ww1 = 0.f;
    if (lane < ntk) { const int tk = gw + NGW * lane; sl0 = T.tok_slot[tk * 2]; sl1 = T.tok_slot[tk * 2 + 1]; ww0 = T.tok_w[tk * 2]; ww1 = T.tok_w[tk * 2 + 1]; }
    for (int i0 = 0; i0 < ntk; i0 += 4) {
        u32x4 xa[4][2], ya[4][2], yb[4][2];
#pragma unroll
        for (int tt = 0; tt < 4; ++tt) { const int i = i0 + tt, tok = gw + NGW * i;
            const int s0 = __builtin_amdgcn_readlane(sl0, i), s1 = __builtin_amdgcn_readlane(sl1, i);
            const GAS u32x4* xr = (const GAS u32x4*)(x + (size_t)tok * D) + lane * 2;
            const GAS u32x4* y0 = (const GAS u32x4*)(Y + (size_t)s0 * D) + lane * 2; const GAS u32x4* y1 = (const GAS u32x4*)(Y + (size_t)s1 * D) + lane * 2;
            xa[tt][0] = xr[0]; xa[tt][1] = xr[1]; ya[tt][0] = y0[0]; ya[tt][1] = y0[1]; yb[tt][0] = y1[0]; yb[tt][1] = y1[1]; }
#pragma unroll
        for (int tt = 0; tt < 4; ++tt) { const int i = i0 + tt, tok = gw + NGW * i;
            const float w0 = __builtin_bit_cast(float, __builtin_amdgcn_readlane(__builtin_bit_cast(int, ww0), i)), w1 = __builtin_bit_cast(float, __builtin_amdgcn_readlane(__builtin_bit_cast(int, ww1), i));
            float s = 0.f;
#pragma unroll
            for (int hh = 0; hh < 2; ++hh) { float v[8];
#pragma unroll
                for (int e = 0; e < 4; ++e) { const unsigned c = xa[tt][hh][e], a = ya[tt][hh][e], b = yb[tt][hh][e];
                    v[2 * e] = bf2f(c & 0xffff) + w0 * bf2f(a & 0xffff) + w1 * bf2f(b & 0xffff); v[2 * e + 1] = bf2f(c >> 16) + w0 * bf2f(a >> 16) + w1 * bf2f(b >> 16);
                    s += v[2 * e] * v[2 * e] + v[2 * e + 1] * v[2 * e + 1]; }
                if (out32) { GAS f32x4* op = (GAS f32x4*)(out32 + (size_t)tok * D) + lane * 4 + hh * 2; op[0] = (f32x4){v[0], v[1], v[2], v[3]}; op[1] = (f32x4){v[4], v[5], v[6], v[7]}; }
                else { u32x4 wv; wv.x = cvtpk(v[0], v[1]); wv.y = cvtpk(v[2], v[3]); wv.z = cvtpk(v[4], v[5]); wv.w = cvtpk(v[6], v[7]); ((GAS u32x4*)(x + (size_t)tok * D) + lane * 2)[hh] = wv; } }
            if (!out32) { const float r = rsqrtf(wave_sum(s) * (1.f / D) + RMS_EPS); if (lane == 0) rs1[tok] = r; } }
    }
}

constexpr int NPHASE = 1 + 8 * DEPTH;
#ifndef PHMASK
#define PHMASK 0x3ff
#endif
#define EN(k) (((PHMASK) >> (k)) & 1)
#ifndef REPMASK
#define REPMASK 0
#endif
#define NREP(k) (1 + (((REPMASK) >> (k)) & 1))
__global__ void __launch_bounds__(NTHREADS, 2) mega(Args a) {
    extern __shared__ __attribute__((aligned(16))) unsigned char lds_raw[];
    Frame F;
    F.lds = (LAS unsigned char*)lds_raw; F.MISC = (volatile LAS unsigned*)(F.lds + MISC_OFF);
    F.tid = threadIdx.x; F.lane = F.tid & 63; F.wave = __builtin_amdgcn_readfirstlane(F.tid >> 6);
    F.G = gridDim.x; F.bx = blockIdx.x; { const int bx = blockIdx.x; F.vcu = (F.G % 8 == 0) ? (bx % 8) * (F.G / 8) + bx / 8 : bx; }
    F.ws = (guc_t)a.ws; F.ctl = (gu_t)(F.ws + WS_CTL);
    for (int u = F.tid; u < 256; u += NTHREADS) F.MISC[u] = 0u;
    __syncthreads();
    const int lo = a.ph_lo, hi = a.ph_hi;
    if (lo >= 100) { Frame FC = F; FC.lane = fresh_lane(); FC.tid = F.wave * 64 + FC.lane; convert_layer(FC, a, lo - 100); return; }
    XcdBarrier bar = xcd_barrier_post((unsigned*)(F.ctl + CW_BAR + lo * XCD_BAR_WORDS), F.MISC + 8, F.wave);
#define IN(k) (lo <= (k) && (k) < hi)
#define SEAM(k) do { if (IN(k) && IN((k) + 1)) xcd_barrier(bar); } while (0)
#define INP(i) ((gcf_t)al.in[i])
#define FRESH(FP) Frame FP = FL; FP.lane = fresh_lane(); FP.tid = FL.wave * 64 + FP.lane

    if (EN(0) && IN(0)) {
        Frame FC = F; FC.lane = fresh_lane(); FC.tid = F.wave * 64 + FC.lane;
        convert_layer(FC, a, 0);
        const int gw = F.vcu * NWAVES + F.wave, NGW = F.G * NWAVES;
        gb_t X0 = (gb_t)(F.ws + WS_X16); gcf_t x0 = (gcf_t)a.in[0]; gf_t rs0 = (gf_t)(F.ws + WS_TOK + 1536 * 1024);
        {
            f32x4 ra[4], rb[4]; int m = gw;
            if (m < M) stream_load(x0 + (size_t)m * D, ra, FC.lane);
            for (; m < M; m += 2 * NGW) {
                const bool hb = m + NGW < M;
                if (hb) stream_load(x0 + (size_t)(m + NGW) * D, rb, FC.lane);
                stream_store(ra, X0 + (size_t)m * D, rs0 + m, FC.lane);
                if (!hb) break;
                const bool ha = m + 2 * NGW < M;
                if (ha) stream_load(x0 + (size_t)(m + 2 * NGW) * D, ra, FC.lane);
                stream_store(rb, X0 + (size_t)(m + NGW) * D, rs0 + m + NGW, FC.lane);
                if (!ha) break;
            }
        }
    }
    SEAM(0);
    for (int L = 0; L < DEPTH; ++L) {
        const int pb = 1 + 8 * L, j = L >> 1; const bool is_na = !(L & 1);
        Frame FL = F; int bxL = (int)blockIdx.x; asm volatile("" : "+s"(FL.vcu), "+s"(FL.G), "+s"(bxL)); FL.bx = bxL;
        guc_t wsL = F.ws; gf_t out = (gf_t)a.out; asm volatile("" : "+s"(wsL), "+s"(out));
        Args al = a;
#pragma unroll
        for (int i = 0; i < 25; ++i) asm volatile("" : "+s"(al.in[i]));
        gb_t Wqkvp = (gb_t)(wsL + WS_WQKVP); gb_t Wo_t = (gb_t)(wsL + WS_WO); gb_t Wgu_t = (gb_t)(wsL + WS_WGU); gb_t Wd_t = (gb_t)(wsL + WS_WD);
        gf_t RS1 = (gf_t)(wsL + WS_TOK + 1536 * 1024), RS2 = (gf_t)(wsL + WS_TOK + 1792 * 1024), SRS = (gf_t)(wsL + WS_TOK + 2048 * 1024);
        gb_t QKV = (gb_t)(wsL + WS_QKV); gb_t AO = (gb_t)(wsL + WS_AO); gb_t Hb = (gb_t)(wsL + WS_H); gb_t Yb = (gb_t)(wsL + WS_Y);
        TokG T; T.tok_e = (gi_t)(wsL + WS_TOK); T.tok_w = (gf_t)(wsL + WS_TOK + 256 * 1024); T.tok_slot = (gi_t)(wsL + WS_TOK + 512 * 1024); T.slot_tok = (gi_t)(wsL + WS_TOK + 768 * 1024);
        gi_t tile_e = (gi_t)(wsL + WS_TOK + 768 * 1024 + 512 * 1024); gb_t X16 = (gb_t)(wsL + WS_X16);
        if (EN(1) && IN(pb)) for (int rep_ = 0; rep_ < NREP(1); ++rep_) { FRESH(FP);
            pg8::DenseOrder S; S.init(M, 3072, 1024, FL.G, bxL, (gcc_t)X16, (gcc_t)Wqkvp);
            pg8::EpiQKV E{QKV, (is_na ? INP(5) : INP(10)) + j * 64, (is_na ? INP(6) : INP(11)) + j * 64, (gcf_t)RS1, is_na ? 1.f : 0.125f * LOG2E, is_na ? (guc_t)nullptr : (guc_t)(wsL + WS_XN), is_na ? (guc_t)nullptr : (guc_t)(wsL + WS_XN + 32 * MiB)};
            pg8::gemm_phase<pg8::EpiQKV, pg8::DenseOrder, false>(FP.tid, FP.lds, 1024, S, E, nullptr);
        }
        SEAM(pb);
        if (IN(pb + 1)) {
            if (!EN(3) || (EN(2) && is_na)) { if (EN(2)) for (int rep_ = 0; rep_ < NREP(2); ++rep_) { FRESH(FP); na_phase(FP, QKV, INP(7) + (size_t)j * 16 * 465, INP(5) + j * 64, INP(6) + j * 64, AO); } }
            else for (int rep_ = 0; rep_ < NREP(3); ++rep_) { FRESH(FP); diff_phase(FP, QKV, (guc_t)(wsL + WS_XN), (guc_t)(wsL + WS_XN + 32 * MiB), INP(17), INP(10) + j * 64, INP(11) + j * 64, INP(12) + j * 64, INP(13) + j * 64, INP(14) + j * 64, INP(15) + j * 64, INP(16) + j * 128,
                            0.8f - 0.6f * __expf(-0.3f * (float)L), AO); }
        }
        SEAM(pb + 1);
        if (EN(4) && IN(pb + 2)) { FRESH(FP);
            pg8::DenseOrder S; S.init(M, 1024, 1024, FL.G, bxL, (gcc_t)AO, (gcc_t)Wo_t);
            pg8::EpiRes<true> E{INP(0), (gcb_t)X16, X16}; pg8::gemm_phase<pg8::EpiRes<true>, pg8::DenseOrder, false>(FP.tid, FP.lds, 1024, S, E, nullptr);
        }
        SEAM(pb + 2);
        gu_t cnt = (gu_t)(wsL + WS_CTL) + CW_CNT + L * 16; gu_t cur = (gu_t)(wsL + WS_CTL) + CW_CUR + L * 16;
        if (EN(5) && IN(pb + 3)) { FRESH(FP); router_phase(FP, (gcb_t)X16, INP(2) + L * 1024, INP(18) + (size_t)L * 1024 * 4, INP(19) + L * 4, INP(20) + (size_t)L * 1024 * 16, INP(21) + L * 16, RS2, T, cnt); }
        SEAM(pb + 3);
        if (EN(6) && IN(pb + 4)) { FRESH(FP); assign_phase(FP, cnt, cur, T, tile_e, (gcf_t)RS2, SRS); }
        SEAM(pb + 4);
        if (EN(7) && IN(pb + 5)) for (int rep_ = 0; rep_ < NREP(7); ++rep_) { FRESH(FP);
            const int ntiles = moe_setup(FP, cnt, T.slot_tok, true);
            pg8::MoeOrder S{ntiles * 4, FL.G, FL.vcu, 1024, (gcc_t)X16, (gcc_t)Wgu_t, (size_t)1024 * 1024 * 2, (const LAS int*)(FP.lds + MISC_OFF + 64), true};
            pg8::EpiGateUp E{Hb, (gcf_t)SRS};
            pg8::gemm_phase<pg8::EpiGateUp, pg8::MoeOrder, true>(FP.tid, FP.lds, 1024, S, E, (const LAS int*)(FP.lds + ROWS_OFF));
        }
        SEAM(pb + 5);
        if (EN(8) && IN(pb + 6)) for (int rep_ = 0; rep_ < NREP(8); ++rep_) { FRESH(FP);
            const int ntiles = moe_setup(FP, cnt, T.slot_tok, false);
            pg8::MoeOrder S{ntiles * 4, FL.G, FL.vcu, 512, (gcc_t)Hb, (gcc_t)Wd_t, (size_t)1024 * 512 * 2, (const LAS int*)(FP.lds + MISC_OFF + 64), false};
            pg8::EpiBf16 E{Yb, 1024};
            pg8::gemm_phase<pg8::EpiBf16, pg8::MoeOrder, false>(FP.tid, FP.lds, 512, S, E, nullptr);
        }
        SEAM(pb + 6);
        if (EN(9) && IN(pb + 7)) { FRESH(FP);
            if (L + 1 < DEPTH) convert_layer(FP, al, L + 1);
            combine_phase(FP, X16, L + 1 < DEPTH ? (gf_t)nullptr : out, Yb, T, RS1);
        }
        SEAM(pb + 7);
    }
#undef IN
#undef SEAM
#undef INP
#undef FRESH
}


#ifndef MK_MODE
#define MK_MODE 1
#endif
#ifndef NEWMASK
#define NEWMASK 0x3ff
#endif
extern "C" void kernel_launch(void* const* d_in, const int* in_sizes, int n_in, void* d_out, int out_size, void* d_ws, size_t ws_size, hipStream_t stream) {
    if (n_in != 25 || ws_size < WS_END2) { fprintf(stderr, "kernel_launch: unexpected n_in %d / ws %zu\n", n_in, ws_size); return; }
    static int grid = 0;
    if (grid == 0) {
        int dev = 0, cus = 0;
        if (hipGetDevice(&dev) != hipSuccess || hipDeviceGetAttribute(&cus, hipDeviceAttributeMultiprocessorCount, dev) != hipSuccess) { grid = -1; return; }
        if (hipFuncSetAttribute((const void*)mega, hipFuncAttributeMaxDynamicSharedMemorySize, LDS_BYTES) != hipSuccess) { grid = -1; return; }
        int per_cu = 0;
        if (hipOccupancyMaxActiveBlocksPerMultiprocessor(&per_cu, (const void*)mega, NTHREADS, LDS_BYTES) != hipSuccess || per_cu < 1) { fprintf(stderr, "kernel_launch: occupancy query says %d\n", per_cu); }
        (void)hipGetLastError();
        grid = cus;
    }
    if (grid < 0) return;
    const float* x = (const float*)d_in[0];
    const float* mix_g = (const float*)d_in[1]; const float* ffn_g = (const float*)d_in[2];
    const float* na_wqkv = (const float*)d_in[3]; const float* na_wo = (const float*)d_in[4]; const float* na_qg = (const float*)d_in[5]; const float* na_kg = (const float*)d_in[6]; const float* na_rpb = (const float*)d_in[7];
    const float* df_wqkv = (const float*)d_in[8]; const float* df_wo = (const float*)d_in[9]; const float* df_qg = (const float*)d_in[10]; const float* df_kg = (const float*)d_in[11];
    const float* lq1 = (const float*)d_in[12]; const float* lk1 = (const float*)d_in[13]; const float* lq2 = (const float*)d_in[14]; const float* lk2 = (const float*)d_in[15];
    const float* subg = (const float*)d_in[16]; const float* rel_bias = (const float*)d_in[17];
    const float* rgw = (const float*)d_in[18]; const float* rgb = (const float*)d_in[19]; const float* rew = (const float*)d_in[20]; const float* reb = (const float*)d_in[21];
    float* out = (float*)d_out; unsigned char* ws = (unsigned char*)d_ws;
    unsigned* ctl = (unsigned*)(ws + WS_CTL);
    bf16_t* Wqkv_t = (bf16_t*)(ws + WS_WQKV); bf16_t* Wo_t = (bf16_t*)(ws + WS_WO); bf16_t* Wgu_t = (bf16_t*)(ws + WS_WGU); bf16_t* Wd_t = (bf16_t*)(ws + WS_WD);
    bf16_t* XN = (bf16_t*)(ws + WS_XN); bf16_t* QKV = (bf16_t*)(ws + WS_QKV); bf16_t* AO = (bf16_t*)(ws + WS_AO); bf16_t* Hb = (bf16_t*)(ws + WS_H); bf16_t* Yb = (bf16_t*)(ws + WS_Y);
    TokArrays T; T.tok_e = (int*)(ws + WS_TOK); T.tok_w = (float*)(ws + WS_TOK + 256 * 1024); T.tok_slot = (int*)(ws + WS_TOK + 512 * 1024); T.slot_tok = (int*)(ws + WS_TOK + 768 * 1024);
    int* tile_e = (int*)(ws + WS_TOK + 768 * 1024 + 512 * 1024);
    float* tbl = (float*)(ws + WS_TBL); float* lamp = (float*)(ws + WS_TBL + 512 * 1024);
    const int BIG = 1 << 30;

    (void)hipMemsetAsync(ws + WS_CTL, 0, 1 * MiB, stream);
    Args a{};
    for (int i = 0; i < 25; ++i) a.in[i] = (const float*)d_in[i];
    a.out = out; a.ws = ws;
#ifndef HOSTREP
#define HOSTREP 0
#endif
#define LAUNCH_MEGA(lo_, hi_) do { a.ph_lo = (lo_); a.ph_hi = (hi_); hipLaunchKernelGGL(mega, dim3(grid), dim3(NTHREADS), LDS_BYTES, stream, a); } while (0)
    if (MK_MODE == 1) { LAUNCH_MEGA(0, NPHASE); return; }
    const unsigned nm = NEWMASK;
    for (int L = 0; L < DEPTH; ++L) {
        const int j = L / 2, pb = 1 + 8 * L; const bool is_na = (L % 2 == 0);
        const float* wqkv = (is_na ? na_wqkv : df_wqkv) + (size_t)j * 1024 * 3072;
        if (nm != 0x3ffu) {
            LAUNCH_MEGA(100 + L, 101 + L);
            k_transpose<<<dim3(3072 / 32, 1024 / 32, 1), 256, 0, stream>>>(wqkv, Wqkv_t, 1024, 3072, BIG, 0, 0, 0, 0, 0);
        }
        if (L == 0) { if (nm & 1u) { LAUNCH_MEGA(0, 1); if (HOSTREP & 1) LAUNCH_MEGA(0, 1); } else k_rmsnorm<<<M / 4, 256, 0, stream>>>(x, mix_g, XN); }
        if (nm & 2u) { LAUNCH_MEGA(pb, pb + 1); if (HOSTREP & 2) LAUNCH_MEGA(pb, pb + 1); }
        else { k_gemm<EpiStoreBf16><<<dim3(3072 / 128, M / 128), 256, 0, stream>>>(XN, Wqkv_t, 1024, 1024, 1024, 0, EpiStoreBf16{QKV, 3072, 0});
               k_qknorm<<<M / 4, 256, 0, stream>>>(QKV, (is_na ? na_qg : df_qg) + j * 64, (is_na ? na_kg : df_kg) + j * 64); }
        if (is_na) { if (nm & 4u) { LAUNCH_MEGA(pb + 1, pb + 2); if (HOSTREP & 4) LAUNCH_MEGA(pb + 1, pb + 2); } else k_na_attn<<<M / 4, 256, 0, stream>>>(QKV, na_rpb + (size_t)j * 16 * 15 * 31, AO); }
        else { if (nm & 8u) { LAUNCH_MEGA(pb + 1, pb + 2); if (HOSTREP & 8) LAUNCH_MEGA(pb + 1, pb + 2); }
               else { const float li = 0.8f - 0.6f * expf(-0.3f * (float)L);
                      k_t5table<<<(8191 * 8 + 255) / 256, 256, 0, stream>>>(rel_bias, tbl, lq1 + j * 64, lk1 + j * 64, lq2 + j * 64, lk2 + j * 64, lamp, li, 0.f);
                      k_diff_attn<<<M / 8, 512, 0, stream>>>(QKV, tbl, lamp, subg + j * 128, AO, 1.f - li, 0.f); } }
        if (nm & 16u) { LAUNCH_MEGA(pb + 2, pb + 3); if ((HOSTREP & 16) && L == 0) for (int r_ = 0; r_ < 4; ++r_) LAUNCH_MEGA(pb + 2, pb + 3); }
        else k_gemm<EpiResidual><<<dim3(1024 / 128, M / 128), 256, 0, stream>>>(AO, Wo_t, 1024, 1024, 1024, 0, EpiResidual{L == 0 ? x : out, out, 1024, 0});
        unsigned* cnt = ctl + CW_CNT + L * 16; unsigned* cur = ctl + CW_CUR + L * 16;
        if (nm & 32u) { LAUNCH_MEGA(pb + 3, pb + 4); if (HOSTREP & 32) { (void)hipMemsetAsync(cnt, 0, 64, stream); LAUNCH_MEGA(pb + 3, pb + 4); } }
        else k_norm_router<<<M / 4, 256, 0, stream>>>(out, ffn_g + L * 1024, rgw + (size_t)L * 1024 * 4, rgb + L * 4, rew + (size_t)L * 1024 * 16, reb + L * 16, XN, T, cnt);
        if (nm & 64u) { LAUNCH_MEGA(pb + 4, pb + 5); if (HOSTREP & 64) { (void)hipMemsetAsync(cur, 0, 64, stream); LAUNCH_MEGA(pb + 4, pb + 5); } } else k_assign<<<M / 256, 256, 0, stream>>>(cnt, cur, T, tile_e);
        if (nm & 128u) { LAUNCH_MEGA(pb + 5, pb + 6); if (HOSTREP & 128) LAUNCH_MEGA(pb + 5, pb + 6); } else k_moe_gateup<<<dim3(512 / 64, CAP / 128), 256, 0, stream>>>(XN, Wgu_t, T.slot_tok, tile_e, Hb);
        if (nm & 256u) { LAUNCH_MEGA(pb + 6, pb + 7); if (HOSTREP & 256) LAUNCH_MEGA(pb + 6, pb + 7); } else k_moe_down<<<dim3(1024 / 128, CAP / 128), 256, 0, stream>>>(Hb, Wd_t, tile_e, Yb);
        if (nm & 512u) LAUNCH_MEGA(pb + 7, pb + 8); else k_combine<<<M / 4, 256, 0, stream>>>(out, Yb, T, L + 1 < DEPTH ? mix_g + (L + 1) * 1024 : nullptr, XN);
    }
}
```

```cpp
#include <hip/hip_runtime.h>
#include <stdint.h>
#include <cstdio>

typedef unsigned short bf16_t;
typedef short bf16x8 __attribute__((ext_vector_type(8)));
typedef float f32x4 __attribute__((ext_vector_type(4)));
typedef unsigned u32x4 __attribute__((ext_vector_type(4)));
typedef unsigned u32x2 __attribute__((ext_vector_type(2)));

constexpr int BATCH = 8, SEQ = 4096, D = 1024, M = BATCH * SEQ, DEPTH = 4;
constexpr int NE = 16, DE = 512, NGRP = 4;
constexpr int CAP = (2 * M / 256 + NE) * 256;
constexpr int MAXT = CAP / 256;
constexpr float RMS_EPS = 1e-6f;

constexpr size_t MiB = 1u << 20;
constexpr size_t WS_CTL = 0;
constexpr size_t WS_WQKV = 1 * MiB;
constexpr size_t WS_WO = 7 * MiB;
constexpr size_t WS_WGU = 9 * MiB;
constexpr size_t WS_WD = 41 * MiB;
constexpr size_t WS_XN = 57 * MiB;
constexpr size_t WS_QKV = 121 * MiB;
constexpr size_t WS_AO = 313 * MiB;
constexpr size_t WS_H = WS_QKV;
constexpr size_t WS_Y = WS_QKV + 68 * MiB;
constexpr size_t WS_TOK = 377 * MiB;
constexpr size_t WS_TBL = 380 * MiB;
constexpr size_t WS_END = 384 * MiB;
constexpr int CW_CNT = 1024;
constexpr int CW_CUR = 2048;

struct TokArrays { int* tok_e; float* tok_w; int* tok_slot; int* slot_tok; };

__device__ __forceinline__ unsigned f2bf(float f) { unsigned u = __builtin_bit_cast(unsigned, f); return (u + 0x7fffu + ((u >> 16) & 1u)) >> 16; }
__device__ __forceinline__ float bf2f(unsigned short b) { return __builtin_bit_cast(float, (unsigned)b << 16); }
__device__ __forceinline__ unsigned pk2(float lo, float hi) { return f2bf(lo) | (f2bf(hi) << 16); }
__device__ __forceinline__ float wave_sum(float v) {
#pragma unroll
    for (int o = 1; o < 64; o <<= 1) v += __shfl_xor(v, o);
    return v;
}

__global__ void __launch_bounds__(256) k_transpose(const float* __restrict__ W, bf16_t* __restrict__ Wt, int K, int N, int grp, int gstride, int goff, int pad_,
                                                   size_t src_bstride, size_t dst_bstride) {
    __shared__ float tile[32][33];
    W += (size_t)blockIdx.z * src_bstride; Wt += (size_t)blockIdx.z * dst_bstride;
    const int n0 = blockIdx.x * 32, k0 = blockIdx.y * 32, tx = threadIdx.x & 31, ty = threadIdx.x >> 5;
#pragma unroll
    for (int i = 0; i < 4; ++i) tile[ty + 8 * i][tx] = W[(size_t)(k0 + ty + 8 * i) * N + n0 + tx];
    __syncthreads();
#pragma unroll
    for (int i = 0; i < 4; ++i) { const int n = n0 + ty + 8 * i; const int dr = (n / grp) * gstride + goff + n % grp;
        Wt[(size_t)dr * K + k0 + tx] = (bf16_t)f2bf(tile[tx][ty + 8 * i]); }
}

__global__ void __launch_bounds__(256) k_rmsnorm(const float* __restrict__ x, const float* __restrict__ g, bf16_t* __restrict__ out) {
    const int lane = threadIdx.x & 63, row = blockIdx.x * 4 + (threadIdx.x >> 6);
    const f32x4* xr = (const f32x4*)(x + (size_t)row * D) + lane;
    f32x4 v[4]; float s = 0.f;
#pragma unroll
    for (int j = 0; j < 4; ++j) { v[j] = xr[64 * j]; s += v[j].x * v[j].x + v[j].y * v[j].y + v[j].z * v[j].z + v[j].w * v[j].w; }
    const float r = rsqrtf(wave_sum(s) * (1.f / D) + RMS_EPS);
    u32x2* o = (u32x2*)(out + (size_t)row * D) + lane;
#pragma unroll
    for (int j = 0; j < 4; ++j) { const f32x4 gg = ((const f32x4*)g)[lane + 64 * j]; u32x2 w; w.x = pk2(v[j].x * r * gg.x, v[j].y * r * gg.y); w.y = pk2(v[j].z * r * gg.z, v[j].w * r * gg.w); o[64 * j] = w; }
}

template <class Epi>
__global__ void __launch_bounds__(256) k_gemm(const bf16_t* __restrict__ A, const bf16_t* __restrict__ Bt, int K, int lda, int ldb, int pad_, Epi E) {
    const int lane = threadIdx.x & 63, wid = threadIdx.x >> 6, wr = wid >> 1, wc = wid & 1, fr = lane & 15, fq = lane >> 4;
    const int row0 = blockIdx.y * 128 + wr * 64, col0 = blockIdx.x * 128 + wc * 64;
    f32x4 acc[4][4];
#pragma unroll
    for (int m = 0; m < 4; ++m)
#pragma unroll
        for (int n = 0; n < 4; ++n) acc[m][n] = (f32x4){0.f, 0.f, 0.f, 0.f};
    const bf16_t* ap = A + (size_t)(row0 + fr) * lda + fq * 8;
    const bf16_t* bp = Bt + (size_t)(col0 + fr) * ldb + fq * 8;
    for (int k = 0; k < K; k += 32) {
        bf16x8 a[4], b[4];
#pragma unroll
        for (int m = 0; m < 4; ++m) a[m] = *(const bf16x8*)(ap + (size_t)m * 16 * lda + k);
#pragma unroll
        for (int n = 0; n < 4; ++n) b[n] = *(const bf16x8*)(bp + (size_t)n * 16 * ldb + k);
#pragma unroll
        for (int m = 0; m < 4; ++m)
#pragma unroll
            for (int n = 0; n < 4; ++n) acc[m][n] = __builtin_amdgcn_mfma_f32_16x16x32_bf16(b[n], a[m], acc[m][n], 0, 0, 0);
    }
#pragma unroll
    for (int m = 0; m < 4; ++m)
#pragma unroll
        for (int n = 0; n < 4; ++n) E(row0 + m * 16 + fr, col0 + n * 16 + fq * 4, acc[m][n]);
}
struct EpiStoreBf16 { bf16_t* C; int ldc; int pad_;
    __device__ __forceinline__ void operator()(int r, int c, f32x4 v) const { u32x2 w; w.x = pk2(v.x, v.y); w.y = pk2(v.z, v.w); *(u32x2*)(C + (size_t)r * ldc + c) = w; } };
struct EpiResidual { const float* base; float* out; int ldc; int pad_;
    __device__ __forceinline__ void operator()(int r, int c, f32x4 v) const { const f32x4 b = *(const f32x4*)(base + (size_t)r * ldc + c); *(f32x4*)(out + (size_t)r * ldc + c) = b + v; } };

__global__ void __launch_bounds__(256) k_qknorm(bf16_t* __restrict__ qkv, const float* __restrict__ qg, const float* __restrict__ kg) {
    const int lane = threadIdx.x & 63, tok = blockIdx.x * 4 + (threadIdx.x >> 6);
    bf16_t* p = qkv + (size_t)tok * 3072;
#pragma unroll
    for (int pass = 0; pass < 4; ++pass) {
        const int e0 = pass * 512 + lane * 8;
        u32x4 raw = *(const u32x4*)(p + e0);
        float v[8];
#pragma unroll
        for (int i = 0; i < 4; ++i) { v[2 * i] = bf2f((unsigned short)(raw[i] & 0xffff)); v[2 * i + 1] = bf2f((unsigned short)(raw[i] >> 16)); }
        float s = 0.f;
#pragma unroll
        for (int i = 0; i < 8; ++i) s += v[i] * v[i];
        s += __shfl_xor(s, 1); s += __shfl_xor(s, 2); s += __shfl_xor(s, 4);
        const float r = rsqrtf(s * (1.f / 64.f) + RMS_EPS);
        const float* g = (e0 < 1024 ? qg : kg) + (e0 & 63);
        u32x4 w;
#pragma unroll
        for (int i = 0; i < 4; ++i) w[i] = pk2(v[2 * i] * r * g[2 * i], v[2 * i + 1] * r * g[2 * i + 1]);
        *(u32x4*)(p + e0) = w;
    }
}

__global__ void __launch_bounds__(256) k_na_attn(const bf16_t* __restrict__ qkv, const float* __restrict__ rpb, bf16_t* __restrict__ ao) {
    const int lane = threadIdx.x & 63, tok = blockIdx.x * 4 + (threadIdx.x >> 6);
    const int b = tok >> 12, t = tok & 4095, r = t >> 6, c = t & 63, h = lane >> 2, sub = lane & 3;
    int rs = r - 4; rs = rs < 0 ? 0 : (rs > 56 ? 56 : rs);
    int cs = c - 8; cs = cs < 0 ? 0 : (cs > 48 ? 48 : cs);
    float q[16], o[16];
    { const bf16_t* qp = qkv + (size_t)tok * 3072 + h * 64 + sub * 16;
#pragma unroll
      for (int i = 0; i < 16; ++i) { q[i] = bf2f(qp[i]); o[i] = 0.f; } }
    float mx = -1e30f, l = 0.f;
    for (int i = 0; i < 8; ++i) for (int j = 0; j < 16; ++j) {
        const int kr = rs + i, kc = cs + j; const size_t kt = (size_t)(b * 4096 + kr * 64 + kc) * 3072;
        const bf16_t* kp = qkv + kt + 1024 + h * 64 + sub * 16; const bf16_t* vp = qkv + kt + 2048 + h * 64 + sub * 16;
        float d = 0.f;
#pragma unroll
        for (int e = 0; e < 16; ++e) d += q[e] * bf2f(kp[e]);
        d += __shfl_xor(d, 1); d += __shfl_xor(d, 2);
        const float s = d * 0.125f + rpb[(h * 15 + (kr - r + 7)) * 31 + (kc - c + 15)];
        const float mn = fmaxf(mx, s), sc = __expf(mx - mn), p = __expf(s - mn);
        l = l * sc + p; mx = mn;
#pragma unroll
        for (int e = 0; e < 16; ++e) o[e] = o[e] * sc + p * bf2f(vp[e]);
    }
    const float il = 1.f / l;
    bf16_t* op = ao + (size_t)tok * 1024 + h * 64 + sub * 16;
#pragma unroll
    for (int e = 0; e < 16; ++e) op[e] = (bf16_t)f2bf(o[e] * il);
}

__global__ void k_t5table(const float* __restrict__ rel_bias, float* __restrict__ tbl, const float* lq1, const float* lk1, const float* lq2, const float* lk2, float* lamp, float lambda_init, float pad_) {
    const int i = blockIdx.x * blockDim.x + threadIdx.x;
    if (i < 8191 * 8) {
        const int rel = i / 8 - 4095, h = i % 8, n = rel < 0 ? -rel : rel;
        int bk;
        if (n < 8) bk = n; else { bk = 8 + (n >= 12) + (n >= 16) + (n >= 23) + (n >= 32) + (n >= 46) + (n >= 64) + (n >= 91); }
        bk += rel > 0 ? 16 : 0;
        tbl[i] = rel_bias[bk * 8 + h];
    }
    if (i == 0) { float s1 = 0.f, s2 = 0.f; for (int e = 0; e < 64; ++e) { s1 += lq1[e] * lk1[e]; s2 += lq2[e] * lk2[e]; } lamp[0] = expf(s1) - expf(s2) + lambda_init; }
}

__global__ void __launch_bounds__(512) k_diff_attn(const bf16_t* __restrict__ qkv, const float* __restrict__ tbl, const float* __restrict__ lamp, const float* __restrict__ subg, bf16_t* __restrict__ ao, float one_minus_li, float pad_) {
    __shared__ __attribute__((aligned(16))) bf16_t kv[16][2048];
    const int lane = threadIdx.x & 63, w = threadIdx.x >> 6, tok = blockIdx.x * 8 + w;
    const int b = tok >> 12, tq = tok & 4095, h = lane >> 3, c = (lane >> 2) & 1, sub = lane & 3;
    float q[16], o[32];
    { const bf16_t* qp = qkv + (size_t)tok * 3072 + h * 128 + c * 64 + sub * 16;
#pragma unroll
      for (int i = 0; i < 16; ++i) q[i] = bf2f(qp[i]);
#pragma unroll
      for (int i = 0; i < 32; ++i) o[i] = 0.f; }
    float mx = -1e30f, l = 0.f;
    for (int k0 = 0; k0 < SEQ; k0 += 16) {
        __syncthreads();
#pragma unroll
        for (int i = 0; i < 8; ++i) { const int idx = threadIdx.x + 512 * i, key = idx >> 8, ch = idx & 255;
            *(u32x4*)(&kv[key][ch * 8]) = *(const u32x4*)(qkv + (size_t)(b * 4096 + k0 + key) * 3072 + 1024 + ch * 8); }
        __syncthreads();
        for (int kk = 0; kk < 16; ++kk) {
            const bf16_t* kp = &kv[kk][h * 128 + c * 64 + sub * 16];
            float d = 0.f;
#pragma unroll
            for (int e = 0; e < 16; ++e) d += q[e] * bf2f(kp[e]);
            d += __shfl_xor(d, 1); d += __shfl_xor(d, 2);
            const float s = d * 0.125f + tbl[(k0 + kk - tq + 4095) * 8 + h];
            const float mn = fmaxf(mx, s), sc = __expf(mx - mn), p = __expf(s - mn);
            l = l * sc + p; mx = mn;
            const bf16_t* vp = &kv[kk][1024 + h * 128 + sub * 32];
#pragma unroll
            for (int e = 0; e < 32; ++e) o[e] = o[e] * sc + p * bf2f(vp[e]);
        }
    }
    const float il = 1.f / l, lam = lamp[0];
    float ss = 0.f; float r[32];
#pragma unroll
    for (int e = 0; e < 32; ++e) { const float mine = o[e] * il; const float other = __shfl_xor(mine, 4); r[e] = mine - lam * other; ss += r[e] * r[e]; }
    ss += __shfl_xor(ss, 1); ss += __shfl_xor(ss, 2);
    const float rn = rsqrtf(ss * (1.f / 128.f) + RMS_EPS) * one_minus_li;
    if (c == 0) { bf16_t* op = ao + (size_t)tok * 1024 + h * 128 + sub * 32;
#pragma unroll
        for (int e = 0; e < 32; ++e) op[e] = (bf16_t)f2bf(r[e] * rn * subg[sub * 32 + e]); }
}

__global__ void __launch_bounds__(256) k_norm_router(const float* __restrict__ x, const float* __restrict__ g, const float* __restrict__ wg, const float* __restrict__ bg,
                                                     const float* __restrict__ we, const float* __restrict__ be, bf16_t* __restrict__ xn, TokArrays T, unsigned* __restrict__ cnt) {
    const int lane = threadIdx.x & 63, tok = blockIdx.x * 4 + (threadIdx.x >> 6);
    const f32x4* xr = (const f32x4*)(x + (size_t)tok * D) + lane;
    f32x4 v[4]; float s = 0.f;
#pragma unroll
    for (int j = 0; j < 4; ++j) { v[j] = xr[64 * j]; s += v[j].x * v[j].x + v[j].y * v[j].y + v[j].z * v[j].z + v[j].w * v[j].w; }
    const float r = rsqrtf(wave_sum(s) * (1.f / D) + RMS_EPS);
    float lg[20];
#pragma unroll
    for (int i = 0; i < 20; ++i) lg[i] = 0.f;
    u32x2* o = (u32x2*)(xn + (size_t)tok * D) + lane;
#pragma unroll
    for (int j = 0; j < 4; ++j) { const f32x4 gg = ((const f32x4*)g)[lane + 64 * j];
        float hv[4] = {v[j].x * r * gg.x, v[j].y * r * gg.y, v[j].z * r * gg.z, v[j].w * r * gg.w};
        u32x2 w; w.x = pk2(hv[0], hv[1]); w.y = pk2(hv[2], hv[3]); o[64 * j] = w;
#pragma unroll
        for (int e = 0; e < 4; ++e) { const int col = (lane + 64 * j) * 4 + e;
            const f32x4 wgv = *(const f32x4*)(wg + (size_t)col * 4);
            lg[0] += hv[e] * wgv.x; lg[1] += hv[e] * wgv.y; lg[2] += hv[e] * wgv.z; lg[3] += hv[e] * wgv.w;
#pragma unroll
            for (int q4 = 0; q4 < 4; ++q4) { const f32x4 wev = *(const f32x4*)(we + (size_t)col * 16 + q4 * 4);
                lg[4 + q4 * 4 + 0] += hv[e] * wev.x; lg[4 + q4 * 4 + 1] += hv[e] * wev.y; lg[4 + q4 * 4 + 2] += hv[e] * wev.z; lg[4 + q4 * 4 + 3] += hv[e] * wev.w; } } }
#pragma unroll
    for (int i = 0; i < 20; ++i) lg[i] = wave_sum(lg[i]);
    if (lane == 0) {
        float gl[4]; int gi = 0; float gm = -1e30f;
#pragma unroll
        for (int i = 0; i < 4; ++i) { gl[i] = lg[i] + bg[i]; if (gl[i] > gm) { gm = gl[i]; gi = i; } }
        float gs = 0.f;
#pragma unroll
        for (int i = 0; i < 4; ++i) gs += __expf(gl[i] - gm);
        const float gp = 1.f / gs;
        float el[4];
#pragma unroll
        for (int i = 0; i < 4; ++i) { float t = 0.f;
#pragma unroll
            for (int gq = 0; gq < 4; ++gq) t = (gq == gi) ? (lg[4 + gq * 4 + i] + be[gq * 4 + i]) : t;
            el[i] = t; }
        int i0 = 0; float m0 = el[0];
#pragma unroll
        for (int i = 1; i < 4; ++i) if (el[i] > m0) { m0 = el[i]; i0 = i; }
        int i1 = -1; float m1 = -1e30f;
#pragma unroll
        for (int i = 0; i < 4; ++i) if (i != i0 && el[i] > m1) { m1 = el[i]; i1 = i; }
        const float e1 = __expf(m1 - m0), w0 = gp / (1.f + e1), w1 = gp * e1 / (1.f + e1);
        const int E0 = gi * 4 + i0, E1 = gi * 4 + i1;
        T.tok_e[tok * 2] = E0; T.tok_e[tok * 2 + 1] = E1; T.tok_w[tok * 2] = w0; T.tok_w[tok * 2 + 1] = w1;
        atomicAdd(&cnt[E0], 1u); atomicAdd(&cnt[E1], 1u);
    }
}

struct MoeMap { int pstart[NE]; int ntiles; };
__device__ __forceinline__ void moe_offsets(const unsigned* cnt, int* pstart, int* pcount) {
    int acc = 0;
#pragma unroll
    for (int e = 0; e < NE; ++e) { const int c = (int)cnt[e]; pstart[e] = acc; pcount[e] = c; acc += (c + 255) / 256 * 256; }
}
__global__ void __launch_bounds__(256) k_assign(const unsigned* __restrict__ cnt, unsigned* __restrict__ cur, TokArrays T, int* __restrict__ tile_e) {
    int pstart[NE], pcount[NE]; moe_offsets(cnt, pstart, pcount);
    const int tok = blockIdx.x * 256 + threadIdx.x;
#pragma unroll
    for (int k = 0; k < 2; ++k) { const int e = T.tok_e[tok * 2 + k]; int ps = 0;
#pragma unroll
        for (int i = 0; i < NE; ++i) ps = (i == e) ? pstart[i] : ps;
        const int slot = ps + (int)atomicAdd(&cur[e], 1u); T.slot_tok[slot] = tok; T.tok_slot[tok * 2 + k] = slot; }
    if (blockIdx.x == 0) {
        for (int i = threadIdx.x; i < NE * 256; i += 256) { const int e = i >> 8, j = i & 255; int ps = 0, pc = 0;
#pragma unroll
            for (int q = 0; q < NE; ++q) { ps = (q == e) ? pstart[q] : ps; pc = (q == e) ? pcount[q] : pc; }
            const int padded = (pc + 255) / 256 * 256; if (pc + j < padded) T.slot_tok[ps + pc + j] = 0; }
        for (int tI = threadIdx.x; tI < MAXT + 1; tI += 256) { int e = -1;
#pragma unroll
            for (int q = 0; q < NE; ++q) { const int padded = (pcount[q] + 255) / 256 * 256; if (tI * 256 >= pstart[q] && tI * 256 < pstart[q] + padded) e = q; }
            tile_e[tI] = e; }
    }
}

__global__ void __launch_bounds__(256) k_moe_gateup(const bf16_t* __restrict__ xn, const bf16_t* __restrict__ wgu, const int* __restrict__ slot_tok, const int* __restrict__ tile_e, bf16_t* __restrict__ H) {
    const int lane = threadIdx.x & 63, wid = threadIdx.x >> 6, wr = wid >> 1, wc = wid & 1, fr = lane & 15, fq = lane >> 4;
    const int row0 = blockIdx.y * 128 + wr * 64; const int e = tile_e[row0 >> 8]; if (e < 0) return;
    const int hid0 = blockIdx.x * 64 + wc * 32;
    const int tile = hid0 >> 7, j0 = hid0 & 127;
    const bf16_t* B = wgu + (size_t)e * 1024 * 1024;
    f32x4 ag[4][2], au[4][2];
#pragma unroll
    for (int m = 0; m < 4; ++m)
#pragma unroll
        for (int n = 0; n < 2; ++n) { ag[m][n] = (f32x4){0.f, 0.f, 0.f, 0.f}; au[m][n] = (f32x4){0.f, 0.f, 0.f, 0.f}; }
    const bf16_t* ap[4];
#pragma unroll
    for (int m = 0; m < 4; ++m) ap[m] = xn + (size_t)slot_tok[row0 + m * 16 + fr] * 1024 + fq * 8;
    const bf16_t* bg = B + (size_t)(tile * 256 + j0 + fr) * 1024 + fq * 8;
    const bf16_t* bu = bg + (size_t)128 * 1024;
    for (int k = 0; k < 1024; k += 32) {
        bf16x8 a[4], g[2], u[2];
#pragma unroll
        for (int m = 0; m < 4; ++m) a[m] = *(const bf16x8*)(ap[m] + k);
#pragma unroll
        for (int n = 0; n < 2; ++n) { g[n] = *(const bf16x8*)(bg + (size_t)n * 16 * 1024 + k); u[n] = *(const bf16x8*)(bu + (size_t)n * 16 * 1024 + k); }
#pragma unroll
        for (int m = 0; m < 4; ++m)
#pragma unroll
            for (int n = 0; n < 2; ++n) { ag[m][n] = __builtin_amdgcn_mfma_f32_16x16x32_bf16(g[n], a[m], ag[m][n], 0, 0, 0); au[m][n] = __builtin_amdgcn_mfma_f32_16x16x32_bf16(u[n], a[m], au[m][n], 0, 0, 0); }
    }
#pragma unroll
    for (int m = 0; m < 4; ++m)
#pragma unroll
        for (int n = 0; n < 2; ++n) { float hv[4];
#pragma unroll
            for (int i = 0; i < 4; ++i) { const float gvv = ag[m][n][i]; hv[i] = gvv / (1.f + __expf(-gvv)) * au[m][n][i]; }
            u32x2 w; w.x = pk2(hv[0], hv[1]); w.y = pk2(hv[2], hv[3]);
            *(u32x2*)(H + (size_t)(row0 + m * 16 + fr) * 512 + hid0 + n * 16 + fq * 4) = w; }
}
__global__ void __launch_bounds__(256) k_moe_down(const bf16_t* __restrict__ H, const bf16_t* __restrict__ wd, const int* __restrict__ tile_e, bf16_t* __restrict__ Y) {
    const int lane = threadIdx.x & 63, wid = threadIdx.x >> 6, wr = wid >> 1, wc = wid & 1, fr = lane & 15, fq = lane >> 4;
    const int row0 = blockIdx.y * 128 + wr * 64, col0 = blockIdx.x * 128 + wc * 64; const int e = tile_e[row0 >> 8]; if (e < 0) return;
    const bf16_t* Bt = wd + (size_t)e * 1024 * 512;
    f32x4 acc[4][4];
#pragma unroll
    for (int m = 0; m < 4; ++m)
#pragma unroll
        for (int n = 0; n < 4; ++n) acc[m][n] = (f32x4){0.f, 0.f, 0.f, 0.f};
    const bf16_t* ap = H + (size_t)(row0 + fr) * 512 + fq * 8; const bf16_t* bp = Bt + (size_t)(col0 + fr) * 512 + fq * 8;
    for (int k = 0; k < 512; k += 32) {
        bf16x8 a[4], b[4];
#pragma unroll
        for (int m = 0; m < 4; ++m) a[m] = *(const bf16x8*)(ap + (size_t)m * 16 * 512 + k);
#pragma unroll
        for (int n = 0; n < 4; ++n) b[n] = *(const bf16x8*)(bp + (size_t)n * 16 * 512 + k);
#pragma unroll
        for (int m = 0; m < 4; ++m)
#pragma unroll
            for (int n = 0; n < 4; ++n) acc[m][n] = __builtin_amdgcn_mfma_f32_16x16x32_bf16(b[n], a[m], acc[m][n], 0, 0, 0);
    }
#pragma unroll
    for (int m = 0; m < 4; ++m)
#pragma unroll
        for (int n = 0; n < 4; ++n) { u32x2 w; w.x = pk2(acc[m][n].x, acc[m][n].y); w.y = pk2(acc[m][n].z, acc[m][n].w);
            *(u32x2*)(Y + (size_t)(row0 + m * 16 + fr) * 1024 + col0 + n * 16 + fq * 4) = w; }
}
__global__ void __launch_bounds__(256) k_combine(float* __restrict__ x, const bf16_t* __restrict__ Y, TokArrays T, const float* __restrict__ gnext, bf16_t* __restrict__ xn) {
    const int lane = threadIdx.x & 63, tok = blockIdx.x * 4 + (threadIdx.x >> 6);
    const int s0 = T.tok_slot[tok * 2], s1 = T.tok_slot[tok * 2 + 1]; const float w0 = T.tok_w[tok * 2], w1 = T.tok_w[tok * 2 + 1];
    f32x4* xr = (f32x4*)(x + (size_t)tok * D) + lane;
    const u32x2* y0 = (const u32x2*)(Y + (size_t)s0 * D) + lane; const u32x2* y1 = (const u32x2*)(Y + (size_t)s1 * D) + lane;
    f32x4 v[4]; float s = 0.f;
#pragma unroll
    for (int j = 0; j < 4; ++j) { v[j] = xr[64 * j]; const u32x2 a = y0[64 * j], b = y1[64 * j];
        v[j].x += w0 * bf2f(a.x & 0xffff) + w1 * bf2f(b.x & 0xffff); v[j].y += w0 * bf2f(a.x >> 16) + w1 * bf2f(b.x >> 16);
        v[j].z += w0 * bf2f(a.y & 0xffff) + w1 * bf2f(b.y & 0xffff); v[j].w += w0 * bf2f(a.y >> 16) + w1 * bf2f(b.y >> 16);
        xr[64 * j] = v[j]; s += v[j].x * v[j].x + v[j].y * v[j].y + v[j].z * v[j].z + v[j].w * v[j].w; }
    if (gnext) { const float r = rsqrtf(wave_sum(s) * (1.f / D) + RMS_EPS); u32x2* o = (u32x2*)(xn + (size_t)tok * D) + lane;
#pragma unroll
        for (int j = 0; j < 4; ++j) { const f32x4 gg = ((const f32x4*)gnext)[lane + 64 * j]; u32x2 w; w.x = pk2(v[j].x * r * gg.x, v[j].y * r * gg.y); w.y = pk2(v[j].z * r * gg.z, v[j].w * r * gg.w); o[64 * j] = w; } }
}

#define LAS __attribute__((address_space(3)))
#define GAS __attribute__((address_space(1)))
typedef GAS const float* gcf_t; typedef GAS float* gf_t; typedef GAS const bf16_t* gcb_t; typedef GAS bf16_t* gb_t; typedef GAS const int* gci_t; typedef GAS int* gi_t;
typedef int v8i32 __attribute__((ext_vector_type(8)));
typedef int i32x4_t __attribute__((ext_vector_type(4)));
typedef GAS unsigned* gu_t; typedef GAS const unsigned* gcu_t; typedef GAS const char* gcc_t; typedef GAS unsigned char* guc_t;
struct TokG { gi_t tok_e; gf_t tok_w; gi_t tok_slot; gi_t slot_tok; };
#define DI __device__ __forceinline__
typedef short s16x4 __attribute__((ext_vector_type(4)));
typedef float f32x16 __attribute__((ext_vector_type(16)));
typedef float f32x2_t __attribute__((ext_vector_type(2)));
typedef __bf16 bf16x2_t __attribute__((ext_vector_type(2)));
constexpr float LOG2E = 1.4426950408889634f;
constexpr int NWAVES = 8, NTHREADS = 512;
constexpr size_t WS_WQKVP = 381 * MiB;
constexpr size_t WS_X16 = 388 * MiB;
constexpr size_t WS_END2 = 452 * MiB;
constexpr int CW_BAR = 16384;
constexpr int RING_BYTES = 131072;
constexpr int MISC_OFF = 147456;
constexpr int ROWS_OFF = MISC_OFF + 1024;
constexpr int LDS_BYTES = 155648;

DI unsigned cvtpk(float lo, float hi) { f32x2_t v = {lo, hi}; bf16x2_t b = __builtin_convertvector(v, bf16x2_t); return __builtin_bit_cast(unsigned, b); }
DI float uni(float v) { return __builtin_bit_cast(float, __builtin_amdgcn_readfirstlane(__builtin_bit_cast(int, v))); }
DI int fresh_lane() { int l; asm volatile("v_mbcnt_lo_u32_b32 %0, -1, 0\n\tv_mbcnt_hi_u32_b32 %0, -1, %0" : "=v"(l)); return l; }
#define SWZ_XOR(v, k) __builtin_bit_cast(float, __builtin_amdgcn_ds_swizzle(__builtin_bit_cast(int, (v)), ((k) << 10) | 0x1f))
DI float wave_max(float v) {
#pragma unroll
    for (int o = 1; o < 64; o <<= 1) v = fmaxf(v, __shfl_xor(v, o));
    return v;
}

#define XB_TMO      128
#define XB_XCNT(j)  (256  + 64 * (j))
#define XB_XSUB(j)  (1280 + 64 * (j))
#define XB_XGEN(j)  (2304 + 64 * (j))
#define XB_TOP      3328
#define XB_TOPGEN   3392
#define XCD_BAR_WORDS 3456
#define XB_SPIN_CAP (1u << 18)
DI unsigned xb_ld(unsigned* p)              { return __hip_atomic_load(p, __ATOMIC_RELAXED, __HIP_MEMORY_SCOPE_AGENT); }
DI unsigned xb_add(unsigned* p, unsigned v) { return __hip_atomic_fetch_add(p, v, __ATOMIC_RELAXED, __HIP_MEMORY_SCOPE_AGENT); }
DI unsigned xb_xcc_id() { return (unsigned)__builtin_amdgcn_s_getreg((3 << 11) | 20) & 0xFu; }
#define XB_SPIN(cond, bar) do { unsigned _sp = 0; while (cond) { __builtin_amdgcn_s_sleep(1); \
    if ((++_sp & 255u) == 0u) { if (xb_ld(&(bar)[XB_TMO])) break; if (_sp > XB_SPIN_CAP) { atomicAdd(&(bar)[XB_TMO], 1u); break; } } } } while (0)
struct XcdBarrier { unsigned* bar; unsigned x; volatile LAS unsigned* st; int wave; };
DI XcdBarrier xcd_barrier_post(unsigned* bar, volatile LAS unsigned* st, int wave) {
    XcdBarrier b; b.bar = bar; b.x = xb_xcc_id(); b.st = st; b.wave = wave;
    if (wave == 0 && fresh_lane() == 0) (void)xb_add(&bar[XB_XCNT(b.x)], 1u);
    return b;
}
DI void xcd_barrier_complete(unsigned* bar, unsigned x, unsigned& nloc, unsigned& nx) {
    const unsigned G = gridDim.x * gridDim.y * gridDim.z;
    unsigned sum, cnt, mine, sp = 0u;
    for (;;) {
        sum = 0u; cnt = 0u; mine = 0u;
#pragma unroll
        for (unsigned j = 0; j < 16; ++j) { const unsigned c = xb_ld(&bar[XB_XCNT(j)]); sum += c; cnt += (c > 0u) ? 1u : 0u; mine = (j == x) ? c : mine; }
        if (sum == G) break;
        __builtin_amdgcn_s_sleep(1);
        if ((++sp & 255u) == 0u) { if (xb_ld(&bar[XB_TMO])) break; if (sp > XB_SPIN_CAP) { atomicAdd(&bar[XB_TMO], 1u); break; } }
    }
    nloc = mine > 0u ? mine : 1u; nx = cnt > 0u ? cnt : 1u;
}
DI void xcd_barrier(const XcdBarrier& b) {
    asm volatile("s_waitcnt vmcnt(0)" ::: "memory");
    __syncthreads();
    if (b.wave == 0 && fresh_lane() == 0) {
        unsigned* bar = b.bar;
        __builtin_amdgcn_s_waitcnt(0);
        unsigned nloc = b.st[0], nx = b.st[1];
        if (nloc == 0u) { xcd_barrier_complete(bar, b.x, nloc, nx); b.st[0] = nloc; b.st[1] = nx; }
        const unsigned old = xb_add(&bar[XB_XSUB(b.x)], 1u);
        const unsigned gen = old / nloc;
        if (old + 1u == (gen + 1u) * nloc) {
            __builtin_amdgcn_fence(__ATOMIC_RELEASE, "agent");
            asm volatile("s_waitcnt vmcnt(0)" ::: "memory");
            const unsigned og = xb_add(&bar[XB_TOP], 1u);
            const unsigned tg = og / nx;
            if (og + 1u == (tg + 1u) * nx) xb_add(&bar[XB_TOPGEN], 1u);
            else XB_SPIN(xb_ld(&bar[XB_TOPGEN]) == tg, bar);
            __builtin_amdgcn_fence(__ATOMIC_ACQUIRE, "agent");
            xb_add(&bar[XB_XGEN(b.x)], 1u);
            asm volatile("s_waitcnt vmcnt(0)" ::: "memory");
        } else {
            XB_SPIN(xb_ld(&bar[XB_XGEN(b.x)]) == gen, bar);
            __builtin_amdgcn_fence(__ATOMIC_ACQUIRE, "agent");
            asm volatile("s_waitcnt vmcnt(0)" ::: "memory");
        }
    }
    __syncthreads();
}

namespace pg8 {
constexpr int BM = 256, BK = 64, HALF = 128, HTB = HALF * BK * 2, STAGE_BYTES = 8 * HTB, NXCD = 8, WGM = 8;
DI int lds_byte(int r, int c) { const int st = (r >> 4) * 2 + (c >> 5), rr = r & 15, cc = c & 31, ob = rr * 64 + cc * 2; return st * 1024 + (ob ^ (((ob >> 9) & 1) << 5)); }
DI void stage_rc(int b, int& R, int& C) { const int st = b / 1024, sb = b % 1024, swz = sb ^ (((sb >> 9) & 1) << 5); R = (st >> 1) * 16 + swz / 64; C = (st & 1) * 32 + (swz % 64) / 2; }
DI int perm32(int rho) { const int n = rho >> 4, i = rho & 15; return 8 * (i >> 2) + 4 * n + (i & 3); }

struct Unit { int pm, pn, hsel; gcc_t A; gcc_t B; };

struct DenseOrder {
    int nM, nN, nwg, G, c, K; gcc_t A; gcc_t B;
    DI void init(int M_, int N_, int K_, int G_, int c_, gcc_t A_, gcc_t B_) { nM = M_ / BM; nN = N_ / BM; nwg = nM * nN; G = G_; c = c_; K = K_; A = A_; B = B_; }
    DI bool next(int i, Unit& u) const {
        const long L = (long)i * G + c; if (L >= nwg) return false;
        int wgid = (int)L; { const int q = nwg / NXCD, r = nwg % NXCD, xcd = wgid % NXCD, off = wgid / NXCD; wgid = (xcd < r ? xcd * (q + 1) : r * (q + 1) + (xcd - r) * q) + off; }
        const int nig = WGM * nN, gid = wgid / nig, fm = gid * WGM, gsz = (nM - fm) < WGM ? (nM - fm) : WGM;
        u.pm = fm + ((wgid % nig) % gsz); u.pn = (wgid % nig) / gsz;
        u.A = A + (size_t)u.pm * BM * K * 2; u.B = B + (size_t)u.pn * BM * K * 2; u.hsel = 0; return true;
    }
};
struct MoeOrder {
    int nunits, G, vc, K; gcc_t A; gcc_t B; size_t bstride; const LAS int* tend; bool gather; int mode;
    DI bool next(int i, Unit& u) const {
        const int nfull = (nunits / G) * G; int L; u.hsel = 0;
        if (mode == 0) { L = i * G + vc; if (L >= nfull) return false; }
        else if (mode == 1) { if (i > 0 || 2 * (nunits - nfull) <= vc) return false; L = nfull + (vc >> 1); u.hsel = vc & 1; }
        else { if (i > 0) return false; L = nfull + vc; if (L >= nunits) return false; }
        const int rt = L >> 2; u.pm = rt; u.pn = L & 3; int e = 0;
#pragma unroll
        for (int j = 0; j < 15; ++j) e += (tend[j] <= rt) ? 1 : 0;
        u.B = B + (size_t)e * bstride + (size_t)u.pn * BM * K * 2;
        u.A = gather ? A : A + (size_t)rt * BM * K * 2; return true;
    }
};

struct EpiQKV {
    static constexpr bool PERM = true;
    gb_t O; gcf_t qg; gcf_t kg; gcf_t rs; float qscale; guc_t q8; guc_t k8;
    DI void operator()(const f32x4 (&acc)[2][2][4][2], const Unit& u, int wr, int wc, int fr, int fq) const {
        const int row0 = u.pm * BM + wr * 64 + fr, colb = u.pn * BM + 64 * wc + 16 * fq;
        const bool nrm = u.pn < 8; gcf_t g = (u.pn < 4 ? qg : kg) + 16 * fq;
        f32x4 gv[2][2];
#pragma unroll
        for (int bj = 0; bj < 2; ++bj)
#pragma unroll
            for (int n = 0; n < 2; ++n) { gv[bj][n] = nrm ? *(const GAS f32x4*)(g + 8 * bj + 4 * n) : (f32x4){1.f, 1.f, 1.f, 1.f}; if (u.pn < 4) gv[bj][n] *= qscale; }
        float rsa[2][4];
#pragma unroll
        for (int ai = 0; ai < 2; ++ai)
#pragma unroll
            for (int m = 0; m < 4; ++m) rsa[ai][m] = rs[row0 + ai * HALF + m * 16];
        asm volatile("" : "+v"(rsa[0][0]), "+v"(rsa[0][1]), "+v"(rsa[0][2]), "+v"(rsa[0][3]), "+v"(rsa[1][0]), "+v"(rsa[1][1]), "+v"(rsa[1][2]), "+v"(rsa[1][3]));
        float ssr[8];
#pragma unroll
        for (int i = 0; i < 8; ++i) { float t = 0.f;
#pragma unroll
            for (int bj = 0; bj < 2; ++bj)
#pragma unroll
                for (int n = 0; n < 2; ++n) { const f32x4 q = acc[i >> 2][bj][i & 3][n] * acc[i >> 2][bj][i & 3][n]; t += (q[0] + q[1]) + (q[2] + q[3]); }
            ssr[i] = t; }
        if (nrm) {
#pragma unroll
            for (int i = 0; i < 8; ++i) ssr[i] += __shfl_xor(ssr[i], 16);
#pragma unroll
            for (int i = 0; i < 8; ++i) ssr[i] += __shfl_xor(ssr[i], 32);
        }
#pragma unroll
        for (int ai = 0; ai < 2; ++ai)
#pragma unroll
            for (int m = 0; m < 4; ++m) {
                const float rsv = rsa[ai][m];
                const float sc = nrm ? rsv * rsqrtf(rsv * rsv * ssr[ai * 4 + m] * (1.f / 64.f) + RMS_EPS) : rsv;
                gb_t rowp = O + (size_t)(row0 + ai * HALF + m * 16) * 3072 + colb;
                const f32x4 a0 = acc[ai][0][m][0] * sc * gv[0][0], b0 = acc[ai][0][m][1] * sc * gv[0][1], a1 = acc[ai][1][m][0] * sc * gv[1][0], b1 = acc[ai][1][m][1] * sc * gv[1][1];
                if (q8 && nrm) {
                    int w0 = 0, w1 = 0, w2 = 0, w3 = 0;
                    w0 = __builtin_amdgcn_cvt_pk_fp8_f32(a0[0], a0[1], w0, false); w0 = __builtin_amdgcn_cvt_pk_fp8_f32(a0[2], a0[3], w0, true);
                    w1 = __builtin_amdgcn_cvt_pk_fp8_f32(b0[0], b0[1], w1, false); w1 = __builtin_amdgcn_cvt_pk_fp8_f32(b0[2], b0[3], w1, true);
                    w2 = __builtin_amdgcn_cvt_pk_fp8_f32(a1[0], a1[1], w2, false); w2 = __builtin_amdgcn_cvt_pk_fp8_f32(a1[2], a1[3], w2, true);
                    w3 = __builtin_amdgcn_cvt_pk_fp8_f32(b1[0], b1[1], w3, false); w3 = __builtin_amdgcn_cvt_pk_fp8_f32(b1[2], b1[3], w3, true);
                    guc_t d8 = (u.pn < 4 ? q8 : k8) + (size_t)(row0 + ai * HALF + m * 16) * 1024 + (colb & 1023);
                    u32x4 w8; w8.x = (unsigned)w0; w8.y = (unsigned)w1; w8.z = (unsigned)w2; w8.w = (unsigned)w3; *(GAS u32x4*)d8 = w8;
                } else {
                    u32x4 wa, wb; wa.x = cvtpk(a0[0], a0[1]); wa.y = cvtpk(a0[2], a0[3]); wa.z = cvtpk(b0[0], b0[1]); wa.w = cvtpk(b0[2], b0[3]);
                    wb.x = cvtpk(a1[0], a1[1]); wb.y = cvtpk(a1[2], a1[3]); wb.z = cvtpk(b1[0], b1[1]); wb.w = cvtpk(b1[2], b1[3]);
                    *(GAS u32x4*)(rowp) = wa; *(GAS u32x4*)(rowp + 8) = wb; }
            }
    }
};
template <bool BASE16> struct EpiRes {
    static constexpr bool PERM = true;
    gcf_t base32; gcb_t base16; gb_t out; guc_t x8;
    DI void operator()(const f32x4 (&acc)[2][2][4][2], const Unit& u, int wr, int wc, int fr, int fq) const {
        const int row0 = u.pm * BM + wr * 64 + fr, col0 = u.pn * BM + wc * 64 + 16 * fq;
        if constexpr (BASE16) {
            u32x4 r[2][4][2];
#pragma unroll
            for (int ai = 0; ai < 2; ++ai)
#pragma unroll
                for (int m = 0; m < 4; ++m)
#pragma unroll
                    for (int bj = 0; bj < 2; ++bj) r[ai][m][bj] = *(const GAS u32x4*)(base16 + (size_t)(row0 + ai * HALF + m * 16) * D + col0 + bj * 8);
            asm volatile("" : "+v"(r[0][0][0]), "+v"(r[0][0][1]), "+v"(r[0][1][0]), "+v"(r[0][1][1]), "+v"(r[0][2][0]), "+v"(r[0][2][1]), "+v"(r[0][3][0]), "+v"(r[0][3][1]));
            asm volatile("" : "+v"(r[1][0][0]), "+v"(r[1][0][1]), "+v"(r[1][1][0]), "+v"(r[1][1][1]), "+v"(r[1][2][0]), "+v"(r[1][2][1]), "+v"(r[1][3][0]), "+v"(r[1][3][1]));
#pragma unroll
            for (int ai = 0; ai < 2; ++ai)
#pragma unroll
                for (int m = 0; m < 4; ++m) { const size_t off = (size_t)(row0 + ai * HALF + m * 16) * D + col0;
                    u32x4 w8;
#pragma unroll
                    for (int bj = 0; bj < 2; ++bj) { const u32x4 rr = r[ai][m][bj];
                        const f32x4 b0 = (f32x4){bf2f((unsigned short)(rr.x & 0xffffu)), bf2f((unsigned short)(rr.x >> 16)), bf2f((unsigned short)(rr.y & 0xffffu)), bf2f((unsigned short)(rr.y >> 16))};
                        const f32x4 b1 = (f32x4){bf2f((unsigned short)(rr.z & 0xffffu)), bf2f((unsigned short)(rr.z >> 16)), bf2f((unsigned short)(rr.w & 0xffffu)), bf2f((unsigned short)(rr.w >> 16))};
                        const f32x4 v0 = b0 + acc[ai][bj][m][0], v1 = b1 + acc[ai][bj][m][1];
                        u32x4 w; w.x = cvtpk(v0[0], v0[1]); w.y = cvtpk(v0[2], v0[3]); w.z = cvtpk(v1[0], v1[1]); w.w = cvtpk(v1[2], v1[3]);
                        *(GAS u32x4*)(out + off + bj * 8) = w;
                        int e0 = 0, e1 = 0;
                        e0 = __builtin_amdgcn_cvt_pk_fp8_f32(v0[0], v0[1], e0, false); e0 = __builtin_amdgcn_cvt_pk_fp8_f32(v0[2], v0[3], e0, true);
                        e1 = __builtin_amdgcn_cvt_pk_fp8_f32(v1[0], v1[1], e1, false); e1 = __builtin_amdgcn_cvt_pk_fp8_f32(v1[2], v1[3], e1, true);
                        if (bj == 0) { w8.x = (unsigned)e0; w8.y = (unsigned)e1; } else { w8.z = (unsigned)e0; w8.w = (unsigned)e1; } }
                    *(GAS u32x4*)(x8 + off) = w8; }
        } else {
#pragma unroll
            for (int ai = 0; ai < 2; ++ai) {
#pragma unroll
                for (int m = 0; m < 4; ++m) { const size_t off = (size_t)(row0 + ai * HALF + m * 16) * D + col0;
#pragma unroll
                    for (int bj = 0; bj < 2; ++bj) { const f32x4 b0 = *(const GAS f32x4*)(base32 + off + bj * 8), b1 = *(const GAS f32x4*)(base32 + off + bj * 8 + 4);
                        const f32x4 v0 = b0 + acc[ai][bj][m][0], v1 = b1 + acc[ai][bj][m][1];
                        u32x4 w; w.x = cvtpk(v0[0], v0[1]); w.y = cvtpk(v0[2], v0[3]); w.z = cvtpk(v1[0], v1[1]); w.w = cvtpk(v1[2], v1[3]);
                        *(GAS u32x4*)(out + off + bj * 8) = w; } }
            }
        }
    }
};
struct EpiGateUp {
    static constexpr bool PERM = true;
    gb_t H; gcf_t srs;
    DI void operator()(const f32x4 (&acc)[2][2][4][2], const Unit& u, int wr, int wc, int fr, int fq) const {
        const int row0 = u.pm * BM + wr * 64 + fr, col0 = u.pn * 128 + wc * 32 + 8 * fq;
        float rsa[2][4];
#pragma unroll
        for (int ai = 0; ai < 2; ++ai)
#pragma unroll
            for (int m = 0; m < 4; ++m) rsa[ai][m] = srs[row0 + ai * HALF + m * 16];
        asm volatile("" : "+v"(rsa[0][0]), "+v"(rsa[0][1]), "+v"(rsa[0][2]), "+v"(rsa[0][3]), "+v"(rsa[1][0]), "+v"(rsa[1][1]), "+v"(rsa[1][2]), "+v"(rsa[1][3]));
#pragma unroll
        for (int ai = 0; ai < 2; ++ai)
#pragma unroll
            for (int m = 0; m < 4; ++m) { float hv[8]; const float rsv = rsa[ai][m];
#pragma unroll
                for (int n = 0; n < 2; ++n)
#pragma unroll
                    for (int i = 0; i < 4; ++i) { const float gvv = acc[ai][0][m][n][i] * rsv; hv[4 * n + i] = gvv * __builtin_amdgcn_rcpf(1.f + __builtin_amdgcn_exp2f(-gvv * LOG2E)) * (acc[ai][1][m][n][i] * rsv); }
                int w0 = 0, w1 = 0;
                w0 = __builtin_amdgcn_cvt_pk_fp8_f32(hv[0], hv[1], w0, false); w0 = __builtin_amdgcn_cvt_pk_fp8_f32(hv[2], hv[3], w0, true);
                w1 = __builtin_amdgcn_cvt_pk_fp8_f32(hv[4], hv[5], w1, false); w1 = __builtin_amdgcn_cvt_pk_fp8_f32(hv[6], hv[7], w1, true);
                u32x2 w; w.x = (unsigned)w0; w.y = (unsigned)w1; *(GAS u32x2*)((guc_t)H + (size_t)(row0 + ai * HALF + m * 16) * DE + col0) = w; }
    }

    DI void half(const f32x4 (&acc)[2][2][4][2], const Unit& u, int wr, int wc, int fr, int fq, int hs) const {
        const int row0 = u.pm * BM + hs * HALF + wr * 64 + fr, col0 = u.pn * 128 + wc * 32 + 8 * fq;
        float rsa[4];
#pragma unroll
        for (int m = 0; m < 4; ++m) rsa[m] = srs[row0 + m * 16];
        asm volatile("" : "+v"(rsa[0]), "+v"(rsa[1]), "+v"(rsa[2]), "+v"(rsa[3]));
#pragma unroll
        for (int m = 0; m < 4; ++m) { float hv[8]; const float rsv = rsa[m];
#pragma unroll
            for (int n = 0; n < 2; ++n)
#pragma unroll
                for (int i = 0; i < 4; ++i) { const float gvv = acc[0][0][m][n][i] * rsv; hv[4 * n + i] = gvv * __builtin_amdgcn_rcpf(1.f + __builtin_amdgcn_exp2f(-gvv * LOG2E)) * (acc[0][1][m][n][i] * rsv); }
            int w0 = 0, w1 = 0;
            w0 = __builtin_amdgcn_cvt_pk_fp8_f32(hv[0], hv[1], w0, false); w0 = __builtin_amdgcn_cvt_pk_fp8_f32(hv[2], hv[3], w0, true);
            w1 = __builtin_amdgcn_cvt_pk_fp8_f32(hv[4], hv[5], w1, false); w1 = __builtin_amdgcn_cvt_pk_fp8_f32(hv[6], hv[7], w1, true);
            u32x2 w; w.x = (unsigned)w0; w.y = (unsigned)w1; *(GAS u32x2*)((guc_t)H + (size_t)(row0 + m * 16) * DE + col0) = w; }
    }
};

struct EpiBf16 {
    static constexpr bool PERM = true;
    gb_t O; int ldc;
    DI void operator()(const f32x4 (&acc)[2][2][4][2], const Unit& u, int wr, int wc, int fr, int fq) const {
        const int row0 = u.pm * BM + wr * 64 + fr, col0 = u.pn * BM + wc * 64 + 16 * fq;
#pragma unroll
        for (int ai = 0; ai < 2; ++ai)
#pragma unroll
            for (int m = 0; m < 4; ++m) { gb_t rowp = O + (size_t)(row0 + ai * HALF + m * 16) * ldc + col0;
#pragma unroll
                for (int bj = 0; bj < 2; ++bj) { const f32x4 v0 = acc[ai][bj][m][0], v1 = acc[ai][bj][m][1];
                    u32x4 w; w.x = cvtpk(v0[0], v0[1]); w.y = cvtpk(v0[2], v0[3]); w.z = cvtpk(v1[0], v1[1]); w.w = cvtpk(v1[2], v1[3]);
                    *(GAS u32x4*)(rowp + bj * 8) = w; } }
    }

    DI void half(const f32x4 (&acc)[2][2][4][2], const Unit& u, int wr, int wc, int fr, int fq, int hs) const {
        const int row0 = u.pm * BM + hs * HALF + wr * 64 + fr, col0 = u.pn * BM + wc * 64 + 16 * fq;
#pragma unroll
        for (int m = 0; m < 4; ++m) { gb_t rowp = O + (size_t)(row0 + m * 16) * ldc + col0;
#pragma unroll
            for (int bj = 0; bj < 2; ++bj) { const f32x4 v0 = acc[0][bj][m][0], v1 = acc[0][bj][m][1];
                u32x4 w; w.x = cvtpk(v0[0], v0[1]); w.y = cvtpk(v0[2], v0[3]); w.z = cvtpk(v1[0], v1[1]); w.w = cvtpk(v1[2], v1[3]);
                *(GAS u32x4*)(rowp + bj * 8) = w; } }
    }
};


struct EpiY8 {
    static constexpr bool PERM = true;
    guc_t O; int ldc;
    DI void operator()(const f32x4 (&acc)[2][2][4][2], const Unit& u, int wr, int wc, int fr, int fq) const {
        const int row0 = u.pm * BM + wr * 64 + fr, col0 = u.pn * BM + wc * 64 + 16 * fq;
#pragma unroll
        for (int ai = 0; ai < 2; ++ai)
#pragma unroll
            for (int m = 0; m < 4; ++m) { u32x4 w8;
#pragma unroll
                for (int bj = 0; bj < 2; ++bj) { const f32x4 v0 = acc[ai][bj][m][0] * 32.f, v1 = acc[ai][bj][m][1] * 32.f;
                    int e0 = 0, e1 = 0;
                    e0 = __builtin_amdgcn_cvt_pk_fp8_f32(v0[0], v0[1], e0, false); e0 = __builtin_amdgcn_cvt_pk_fp8_f32(v0[2], v0[3], e0, true);
                    e1 = __builtin_amdgcn_cvt_pk_fp8_f32(v1[0], v1[1], e1, false); e1 = __builtin_amdgcn_cvt_pk_fp8_f32(v1[2], v1[3], e1, true);
                    if (bj == 0) { w8.x = (unsigned)e0; w8.y = (unsigned)e1; } else { w8.z = (unsigned)e0; w8.w = (unsigned)e1; } }
                *(GAS u32x4*)(O + (size_t)(row0 + ai * HALF + m * 16) * ldc + col0) = w8; }
    }
    DI void half(const f32x4 (&acc)[2][2][4][2], const Unit& u, int wr, int wc, int fr, int fq, int hs) const {
        const int row0 = u.pm * BM + hs * HALF + wr * 64 + fr, col0 = u.pn * BM + wc * 64 + 16 * fq;
#pragma unroll
        for (int m = 0; m < 4; ++m) { u32x4 w8;
#pragma unroll
            for (int bj = 0; bj < 2; ++bj) { const f32x4 v0 = acc[0][bj][m][0] * 32.f, v1 = acc[0][bj][m][1] * 32.f;
                int e0 = 0, e1 = 0;
                e0 = __builtin_amdgcn_cvt_pk_fp8_f32(v0[0], v0[1], e0, false); e0 = __builtin_amdgcn_cvt_pk_fp8_f32(v0[2], v0[3], e0, true);
                e1 = __builtin_amdgcn_cvt_pk_fp8_f32(v1[0], v1[1], e1, false); e1 = __builtin_amdgcn_cvt_pk_fp8_f32(v1[2], v1[3], e1, true);
                if (bj == 0) { w8.x = (unsigned)e0; w8.y = (unsigned)e1; } else { w8.z = (unsigned)e0; w8.w = (unsigned)e1; } }
            *(GAS u32x4*)(O + (size_t)(row0 + m * 16) * ldc + col0) = w8; }
    }
};


template <class Epi, class Sched, bool GATHER, bool F8 = false, bool HALFU = false>
DI void gemm_phase(const int tid, LAS unsigned char* lds, const int K, const Sched& S, const Epi& E, const LAS int* rows_lds) {
    const int wid = __builtin_amdgcn_readfirstlane(tid >> 6), lane = tid & 63, wr = wid >> 2, wc = wid & 3, fr = lane & 15, fq = lane >> 4;
    const int nt = K / BK;
    const int f8sa = 0x7A7A7A7A, f8sb = 0x7F7F7F7F;
    unsigned voffA[2], voffB[2]; int R0 = 0, C0 = 0;
#pragma unroll
    for (int i = 0; i < 2; ++i) { int R, C; stage_rc(tid * 16 + i * 8192, R, C); const int Rb = Epi::PERM ? ((R & ~31) + perm32(R & 31)) : R;
        voffA[i] = (unsigned)(R * K + C) * 2u; voffB[i] = (unsigned)(Rb * K + C) * 2u; if (i == 0) { R0 = R; C0 = C; } }
    const size_t kstep = (size_t)(BK * 2);
    const size_t hstep = (size_t)HALF * K * 2;
    const unsigned ldsw = (unsigned)wid * 1024u;
    const int aoff = lds_byte(wr * 64 + fr, fq * 8), boff = lds_byte(wc * 32 + fr, fq * 8);
#define PG8_SA(b, h) (((b) * 2 + (h)) * HTB)
#define PG8_SB(b, h) ((4 + (b) * 2 + (h)) * HTB)
#define PG8_STAGE(bufoff, gbase, voff) do { _Pragma("unroll") for (int _i = 0; _i < 2; ++_i) \
        __builtin_amdgcn_global_load_lds((const GAS unsigned*)((gcc_t)(gbase) + (voff)[_i]), (LAS unsigned*)(lds + (bufoff) + ldsw + _i * 8192), 16, 0, 0); } while (0)
#define PG8_STAGE_A(bufoff, kbase, h, GV) do { if constexpr (GATHER) { PG8_STAGE(bufoff, kbase, GV[h]); } else { PG8_STAGE(bufoff, (kbase) + (size_t)((h) ^ hs) * hstep, voffA); } } while (0)
#define PG8_LDA(dst, b, h) do { _Pragma("unroll") for (int m = 0; m < 4; ++m) _Pragma("unroll") for (int k = 0; k < 2; ++k) dst[m][k] = *(const LAS bf16x8*)(lds + PG8_SA(b, h) + aoff + m * 2048 + k * 1024); } while (0)
#define PG8_LDB(dst, b, h) do { _Pragma("unroll") for (int n = 0; n < 2; ++n) _Pragma("unroll") for (int k = 0; k < 2; ++k) dst[n][k] = *(const LAS bf16x8*)(lds + PG8_SB(b, h) + boff + n * 2048 + k * 1024); } while (0)
#define PG8_CAT8(x0_, x1_) __builtin_shufflevector(__builtin_bit_cast(i32x4_t, x0_), __builtin_bit_cast(i32x4_t, x1_), 0, 1, 2, 3, 4, 5, 6, 7)
#define PG8_MMA(ai, bj, At, Bt) do { __builtin_amdgcn_s_setprio(1); \
        if constexpr (F8) { _Pragma("unroll") for (int m = 0; m < 4; ++m) _Pragma("unroll") for (int n = 0; n < 2; ++n) \
            { const v8i32 b8_ = PG8_CAT8(Bt[n][0], Bt[n][1]), a8_ = PG8_CAT8(At[m][0], At[m][1]);     \
              asm volatile("v_mfma_scale_f32_16x16x128_f8f6f4 %0, %1, %2, %0, %3, %4 op_sel_hi:[0,0,0]" : "+v"(acc[ai][bj][m][n]) : "v"(b8_), "v"(a8_), "v"(f8sa), "v"(f8sb)); } } \
        else { _Pragma("unroll") for (int m = 0; m < 4; ++m) _Pragma("unroll") for (int n = 0; n < 2; ++n) _Pragma("unroll") for (int k = 0; k < 2; ++k) \
            acc[ai][bj][m][n] = __builtin_amdgcn_mfma_f32_16x16x32_bf16(Bt[n][k], At[m][k], acc[ai][bj][m][n], 0, 0, 0); } \
        __builtin_amdgcn_s_setprio(0); } while (0)
#define PG8_WAIT_V(n) asm volatile("s_waitcnt vmcnt(" #n ")" ::: "memory")
#define PG8_WAIT_L(n) asm volatile("s_waitcnt lgkmcnt(" #n ")" ::: "memory")
#define PG8_BAR __builtin_amdgcn_s_barrier()
#define PG8_SCHED __builtin_amdgcn_sched_barrier(0)
#define PG8_ROWS(dst, ui_) do { int R0_, C0_; stage_rc((wid * 64 + fresh_lane()) * 16, R0_, C0_); _Pragma("unroll") for (int _h = 0; _h < 2; ++_h) _Pragma("unroll") for (int _j = 0; _j < 2; ++_j) \
        dst[_h][_j] = (unsigned)(rows_lds[(ui_) * 256 + _h * 128 + R0_ + 64 * _j] * K + C0_) * 2u; } while (0)
    Unit cur, nxt; int ui = 0;
    if (!S.next(0, cur)) return;
    const int hs = HALFU ? cur.hsel : 0;
    f32x4 acc[2][2][4][2];
#pragma unroll
    for (int a = 0; a < 2; ++a)
#pragma unroll
        for (int b = 0; b < 2; ++b)
#pragma unroll
            for (int m = 0; m < 4; ++m)
#pragma unroll
                for (int n = 0; n < 2; ++n) acc[a][b][m][n] = (f32x4){0.f, 0.f, 0.f, 0.f};
    bf16x8 At[4][2], B0[2][2], B1[2][2];
    gcc_t cA = cur.A; gcc_t cB = cur.B;
    unsigned gC[2][2] = {{0u, 0u}, {0u, 0u}}, gN[2][2] = {{0u, 0u}, {0u, 0u}};
    if constexpr (GATHER) { PG8_ROWS(gC, 0); }
    if constexpr (GATHER && HALFU) {
#pragma unroll
        for (int j = 0; j < 2; ++j) { const unsigned x0 = gC[0][j], x1 = gC[1][j]; gC[0][j] = hs ? x1 : x0; gC[1][j] = hs ? x0 : x1; } }
    PG8_STAGE(PG8_SB(0, 0), cB, voffB); PG8_STAGE(PG8_SB(0, 1), cB + hstep, voffB); PG8_STAGE_A(PG8_SA(0, 0), cA, 0, gC); PG8_STAGE_A(PG8_SA(0, 1), cA, 1, gC);
    if (wr == 1) PG8_BAR;
    PG8_WAIT_V(2); PG8_BAR;
    PG8_STAGE(PG8_SB(1, 0), cB + kstep, voffB); PG8_STAGE_A(PG8_SA(1, 0), cA + kstep, 0, gC); PG8_STAGE(PG8_SB(1, 1), cB + hstep + kstep, voffB);
    PG8_WAIT_V(6); PG8_BAR;
    for (;;) {
        const bool has_next = S.next(ui + 1, nxt);
        gcc_t nA = has_next ? nxt.A : cA; gcc_t nB = has_next ? nxt.B : cB;
        if constexpr (GATHER) { if (has_next) { PG8_ROWS(gN, ui + 1); } else {
#pragma unroll
            for (int h = 0; h < 2; ++h)
#pragma unroll
                for (int j = 0; j < 2; ++j) gN[h][j] = gC[h][j]; } }
        for (int t = 0; t < nt; t += 2) {
            const bool last = (t == nt - 2);
            gcc_t a1 = cA + (size_t)(t + 1) * kstep;
            gcc_t a2 = last ? nA : cA + (size_t)(t + 2) * kstep; gcc_t b2 = last ? nB : cB + (size_t)(t + 2) * kstep;
            gcc_t a3 = a2 + kstep; gcc_t b3 = b2 + kstep;
            unsigned g2[2][2];
#pragma unroll
            for (int h = 0; h < 2; ++h)
#pragma unroll
                for (int j = 0; j < 2; ++j) g2[h][j] = last ? gN[h][j] : gC[h][j];
            PG8_LDB(B0, 0, 0); PG8_LDB(B1, 0, 1); PG8_SCHED; PG8_LDA(At, 0, 0); PG8_STAGE_A(PG8_SA(1, 1), a1, 1, gC);
            PG8_WAIT_V(8); PG8_WAIT_L(0); PG8_BAR; PG8_MMA(0, 0, At, B0); PG8_MMA(0, 1, At, B1); PG8_BAR; PG8_SCHED;
            if constexpr (!HALFU) PG8_LDA(At, 0, 1); PG8_STAGE(PG8_SB(0, 0), b2, voffB); PG8_STAGE(PG8_SB(0, 1), b2 + hstep, voffB); PG8_STAGE_A(PG8_SA(0, 0), a2, 0, g2);
            PG8_WAIT_V(8); PG8_WAIT_L(0); PG8_BAR; if constexpr (!HALFU) { PG8_MMA(1, 0, At, B0); PG8_MMA(1, 1, At, B1); } PG8_BAR; PG8_SCHED;
            PG8_LDB(B0, 1, 0); PG8_LDB(B1, 1, 1); PG8_SCHED; PG8_LDA(At, 1, 0); PG8_STAGE_A(PG8_SA(0, 1), a2, 1, g2);
            PG8_WAIT_V(8); PG8_WAIT_L(0); PG8_BAR; PG8_MMA(0, 0, At, B0); PG8_MMA(0, 1, At, B1); PG8_BAR; PG8_SCHED;
            if constexpr (!HALFU) PG8_LDA(At, 1, 1); PG8_STAGE(PG8_SB(1, 0), b3, voffB); PG8_STAGE(PG8_SB(1, 1), b3 + hstep, voffB); PG8_STAGE_A(PG8_SA(1, 0), a3, 0, g2);
            PG8_WAIT_V(8); PG8_WAIT_L(0); PG8_BAR; if constexpr (!HALFU) { PG8_MMA(1, 0, At, B0); PG8_MMA(1, 1, At, B1); } PG8_BAR; PG8_SCHED;
        }
        if (wr == 0) PG8_BAR;
        { const int ln_ = fresh_lane();
          if constexpr (HALFU) E.half(acc, cur, wr, wc, ln_ & 15, ln_ >> 4, hs); else E(acc, cur, wr, wc, ln_ & 15, ln_ >> 4); }
        if (!has_next) break;
#pragma unroll
        for (int a = 0; a < 2; ++a)
#pragma unroll
            for (int b = 0; b < 2; ++b)
#pragma unroll
                for (int m = 0; m < 4; ++m)
#pragma unroll
                    for (int n = 0; n < 2; ++n) acc[a][b][m][n] = (f32x4){0.f, 0.f, 0.f, 0.f};
        cur = nxt; cA = nA; cB = nB; ++ui;
        if constexpr (GATHER) {
#pragma unroll
            for (int h = 0; h < 2; ++h)
#pragma unroll
                for (int j = 0; j < 2; ++j) gC[h][j] = gN[h][j]; }
        if (wr == 1) PG8_BAR;
    }
    PG8_WAIT_V(0);
    PG8_BAR;
#undef PG8_SA
#undef PG8_SB
#undef PG8_STAGE
#undef PG8_STAGE_A
#undef PG8_LDA
#undef PG8_LDB
#undef PG8_MMA
#undef PG8_CAT8
#undef PG8_WAIT_V
#undef PG8_WAIT_L
#undef PG8_BAR
#undef PG8_SCHED
#undef PG8_ROWS
}
}

struct Args { const float* in[25]; float* out; unsigned char* ws; int ph_lo, ph_hi; };
struct Frame {
    LAS unsigned char* lds; volatile LAS unsigned* MISC; gu_t ctl;
    int tid, lane, wave, vcu, G, bx;
    guc_t ws;
};

DI int dst_row(int mode, int n) {
    if (mode == 1) { const int t = n >> 8, lc = n & 255; return t * 256 + 128 * ((lc >> 3) & 1) + 32 * (lc >> 6) + 8 * ((lc >> 4) & 3) + (lc & 7); }
    if (mode == 2) return (n >> 7) * 256 + (n & 127);
    if (mode == 3) return (n >> 7) * 256 + 128 + (n & 127);
    return n;
}
struct TrItem { gcf_t W; gb_t WT; gcf_t gain; int K, N, mode, item, f8; };
DI void tr_load(const TrItem& t, float (&wv)[32], float& g0, int lane) {
    const int nblk = t.N / 32, kb = t.item / nblk, nb = t.item % nblk, k0 = 64 * kb, n0 = 32 * nb;
#pragma unroll
    for (int i = 0; i < 32; ++i) { const int kk = 2 * i + (lane >> 5); wv[i] = __builtin_nontemporal_load(&t.W[(size_t)(k0 + kk) * t.N + n0 + (lane & 31)]); }
    { gcf_t gp = t.gain ? t.gain : t.W; g0 = gp[k0 + lane]; }
}
DI void tr_store(const TrItem& t, const float (&wv)[32], float g0, LAS float* scr, int lane) {
    const int nblk = t.N / 32, kb = t.item / nblk, nb = t.item % nblk, k0 = 64 * kb, n0 = 32 * nb;
    const float g1 = t.gain ? g0 : 1.f;
#pragma unroll
    for (int i = 0; i < 32; ++i) { const int kk = 2 * i + (lane >> 5); const float gk = __builtin_bit_cast(float, __builtin_amdgcn_ds_bpermute(kk * 4, __builtin_bit_cast(int, g1))); scr[kk * 33 + (lane & 31)] = wv[i] * gk; }
    asm volatile("s_waitcnt lgkmcnt(0)" ::: "memory");
    const int c = lane & 7;
#pragma unroll
    for (int j = 0; j < 4; ++j) { const int n = (lane >> 3) + 8 * j; const LAS float* sp = scr + (8 * c) * 33 + n;
        u32x4 o; o.x = cvtpk(sp[0 * 33], sp[1 * 33]); o.y = cvtpk(sp[2 * 33], sp[3 * 33]); o.z = cvtpk(sp[4 * 33], sp[5 * 33]); o.w = cvtpk(sp[6 * 33], sp[7 * 33]);
        if (t.f8) { int w0 = 0, w1 = 0;
            w0 = __builtin_amdgcn_cvt_pk_fp8_f32(sp[0 * 33] * 32.f, sp[1 * 33] * 32.f, w0, false); w0 = __builtin_amdgcn_cvt_pk_fp8_f32(sp[2 * 33] * 32.f, sp[3 * 33] * 32.f, w0, true);
            w1 = __builtin_amdgcn_cvt_pk_fp8_f32(sp[4 * 33] * 32.f, sp[5 * 33] * 32.f, w1, false); w1 = __builtin_amdgcn_cvt_pk_fp8_f32(sp[6 * 33] * 32.f, sp[7 * 33] * 32.f, w1, true);
            u32x2 o8; o8.x = (unsigned)w0; o8.y = (unsigned)w1; *(GAS u32x2*)((guc_t)t.WT + (size_t)dst_row(t.mode, n0 + n) * t.K + k0 + 8 * c) = o8; }
        else __builtin_nontemporal_store(o, (GAS u32x4*)(t.WT + (size_t)dst_row(t.mode, n0 + n) * t.K + k0 + 8 * c)); }
    asm volatile("s_waitcnt lgkmcnt(0)" ::: "memory");
}
DI TrItem conv_decode(const Frame& F, const Args& a, int L, int it) {
    const int j = L >> 1; const bool is_na = !(L & 1);
    constexpr int I_QKV = 16 * 96, I_O = 16 * 32, I_G = 16 * 256;
    TrItem t; t.f8 = 0; int r = it;
    if (r < I_QKV) { t.W = (gcf_t)a.in[is_na ? 3 : 8] + (size_t)j * 1024 * 3072; t.WT = (gb_t)(F.ws + WS_WQKVP); t.gain = (gcf_t)a.in[1] + L * 1024; t.K = 1024; t.N = 3072; t.mode = 1; t.item = r; return t; } r -= I_QKV;
    if (r < I_O) { t.W = (gcf_t)a.in[is_na ? 4 : 9] + (size_t)j * 1024 * 1024; t.WT = (gb_t)(F.ws + WS_WO); t.gain = (gcf_t)nullptr; t.K = 1024; t.N = 1024; t.mode = 1; t.item = r; t.f8 = 1; return t; } r -= I_O;
    if (r < 2 * I_G) { const int up = r >= I_G; r -= up * I_G; const int e = r >> 8;
        t.W = (gcf_t)a.in[22 + up] + (size_t)L * 16 * 1024 * 512 + (size_t)e * 1024 * 512; t.WT = (gb_t)(F.ws + WS_WGU) + (size_t)e * 1024 * 1024; t.gain = (gcf_t)a.in[2] + L * 1024; t.K = 1024; t.N = 512; t.mode = 2 + up; t.item = r & 255; t.f8 = 1; return t; }
    r -= 2 * I_G;
    { const int e = r >> 8; t.W = (gcf_t)a.in[24] + (size_t)L * 16 * 512 * 1024 + (size_t)e * 512 * 1024; t.WT = (gb_t)(F.ws + WS_WD) + (size_t)e * 1024 * 512; t.gain = (gcf_t)nullptr; t.K = 512; t.N = 1024; t.mode = 1; t.item = r & 255; t.f8 = 1; return t; }
}
DI void convert_layer(const Frame& F, const Args& a, int L) {
    LAS float* scr = (LAS float*)(F.lds + F.wave * 16384);
    const int gw = F.vcu * NWAVES + F.wave, NGW = F.G * NWAVES;
    constexpr int NITEMS = 16 * 96 + 16 * 32 + 3 * 16 * 256;
    int it = gw; if (it >= NITEMS) return;
    TrItem ta = conv_decode(F, a, L, it), tb = ta; float va[32], vb[32], ga, gb;
    tr_load(ta, va, ga, F.lane);
    for (;;) {
        const bool hb = it + NGW < NITEMS;
        if (hb) { tb = conv_decode(F, a, L, it + NGW); tr_load(tb, vb, gb, F.lane); }
        tr_store(ta, va, ga, scr, F.lane);
        if (!hb) break;
        it += NGW;
        const bool ha = it + NGW < NITEMS;
        if (ha) { ta = conv_decode(F, a, L, it + NGW); tr_load(ta, va, ga, F.lane); }
        tr_store(tb, vb, gb, scr, F.lane);
        if (!ha) break;
        it += NGW;
    }
}
DI void stream_load(gcf_t xrow, f32x4 (&v)[4], int lane) {
    const GAS f32x4* xr = (const GAS f32x4*)xrow + lane;
#pragma unroll
    for (int j = 0; j < 4; ++j) v[j] = xr[64 * j];
}
DI void stream_store(const f32x4 (&v)[4], gb_t orow, gf_t rs, int lane) {
    float s = 0.f;
#pragma unroll
    for (int j = 0; j < 4; ++j) s += (v[j].x * v[j].x + v[j].y * v[j].y) + (v[j].z * v[j].z + v[j].w * v[j].w);
    const float r = rsqrtf(wave_sum(s) * (1.f / D) + RMS_EPS);
    GAS u32x2* o = (GAS u32x2*)orow + lane;
#pragma unroll
    for (int j = 0; j < 4; ++j) { u32x2 w; w.x = cvtpk(v[j].x, v[j].y); w.y = cvtpk(v[j].z, v[j].w); o[64 * j] = w; }
    if (lane == 0) *rs = r;
}

DI void glds16(const GAS void* gsrc, unsigned lds_dst) { unsigned keep;
    asm volatile("s_mov_b32 %0, m0\n\ts_mov_b32 m0, %2\n\ts_nop 0\n\tglobal_load_lds_dwordx4 %1, off\n\ts_mov_b32 m0, %0" : "=&s"(keep) : "v"(gsrc), "s"(lds_dst) : "memory"); }
#define ATT_WAIT_BAR() asm volatile("s_waitcnt vmcnt(0) lgkmcnt(0)\n\ts_barrier" ::: "memory")
DI int crow(int r, int hi) { return (r & 3) + 8 * (r >> 2) + 4 * hi; }
DI s16x4 vtr(const LAS char* p) { return __builtin_bit_cast(s16x4, __builtin_amdgcn_ds_read_tr16_b64_v4i16((LAS s16x4*)p)); }
DI bf16x8 pack8(const f32x16& x, int s) {
    u32x4 p; p.x = cvtpk(x[8 * s], x[8 * s + 1]); p.y = cvtpk(x[8 * s + 2], x[8 * s + 3]); p.z = cvtpk(x[8 * s + 4], x[8 * s + 5]); p.w = cvtpk(x[8 * s + 6], x[8 * s + 7]);
    return __builtin_bit_cast(bf16x8, p);
}
#define MFMA32(a, b, c) __builtin_amdgcn_mfma_f32_32x32x16_bf16((a), (b), (c), 0, 0, 0)

DI void glds16s(const GAS void* sbase, unsigned voff, unsigned lds_dst) { unsigned keep;
    asm volatile("s_mov_b32 %0, m0\n\ts_mov_b32 m0, %3\n\ts_nop 0\n\tglobal_load_lds_dwordx4 %1, %2\n\ts_mov_b32 m0, %0" : "=&s"(keep) : "v"(voff), "s"(sbase), "s"(lds_dst) : "memory"); }
DI void glds16s_pair(const GAS void* sbase, unsigned voff, unsigned dst0, unsigned dst1m) { unsigned keep;
    asm volatile("s_mov_b32 %0, m0\n\ts_mov_b32 m0, %3\n\ts_nop 0\n\tglobal_load_lds_dwordx4 %1, %2\n\ts_mov_b32 m0, %4\n\ts_nop 0\n\tglobal_load_lds_dwordx4 %1, %2 offset:128\n\ts_mov_b32 m0, %0"
                 : "=&s"(keep) : "v"(voff), "s"(sbase), "s"(dst0), "s"(dst1m) : "memory"); }
DI void glds16s_kv(const GAS void* sbase, unsigned voffk, unsigned voffv, unsigned dstk, unsigned dstvm) { unsigned keep;
    asm volatile("s_mov_b32 %0, m0\n\ts_mov_b32 m0, %3\n\ts_nop 0\n\tglobal_load_lds_dwordx4 %1, %2\n\ts_mov_b32 m0, %4\n\ts_nop 0\n\tglobal_load_lds_dwordx4 %5, %2 offset:2048\n\ts_mov_b32 m0, %0"
                 : "=&s"(keep) : "v"(voffk), "s"(sbase), "s"(dstk), "s"(dstvm), "v"(voffv) : "memory"); }
DI void na_wait_bar(int n) {
    if (n >= 12) asm volatile("s_waitcnt vmcnt(12) lgkmcnt(0)\n\ts_barrier" ::: "memory");
    else if (n >= 8) asm volatile("s_waitcnt vmcnt(8) lgkmcnt(0)\n\ts_barrier" ::: "memory");
    else if (n >= 6) asm volatile("s_waitcnt vmcnt(6) lgkmcnt(0)\n\ts_barrier" ::: "memory");
    else if (n >= 4) asm volatile("s_waitcnt vmcnt(4) lgkmcnt(0)\n\ts_barrier" ::: "memory");
    else if (n >= 2) asm volatile("s_waitcnt vmcnt(2) lgkmcnt(0)\n\ts_barrier" ::: "memory");
    else if (n >= 1) asm volatile("s_waitcnt vmcnt(1) lgkmcnt(0)\n\ts_barrier" ::: "memory");
    else asm volatile("s_waitcnt vmcnt(0) lgkmcnt(0)\n\ts_barrier" ::: "memory");
}
DI void glds16s_2(const GAS void* sbk, unsigned vok, unsigned dstk, const GAS void* sbv, unsigned vov, unsigned dstv) { unsigned keep;
    asm volatile("s_mov_b32 %0, m0\n\ts_mov_b32 m0, %3\n\ts_nop 0\n\tglobal_load_lds_dwordx4 %1, %2\n\ts_mov_b32 m0, %6\n\ts_nop 0\n\tglobal_load_lds_dwordx4 %4, %5\n\ts_mov_b32 m0, %0"
                 : "=&s"(keep) : "v"(vok), "s"(sbk), "s"(dstk), "v"(vov), "s"(sbv), "s"(dstv) : "memory"); }
DI void na_phase(const Frame& F, gcb_t QKV, guc_t Q8, guc_t K8, gcf_t rpb, gcf_t qg, gcf_t kg, gb_t AO) {
    const int w = F.wave;
    LAS char* const L0 = (LAS char*)F.lds;
    LAS float* const TBL = (LAS float*)(L0 + 65536);
    LAS float* const wsc = (LAS float*)(L0 + 67584) + w * 64;
    const unsigned lds0 = (unsigned)(uintptr_t)L0;
    const float shift = uni(8.f * wave_max(fabsf(qg[F.lane])) * wave_max(fabsf(kg[F.lane])));
    const float c1 = 0.125f * LOG2E;
    constexpr int NU = BATCH * 16 * 16;
    ATT_WAIT_BAR();
    if (F.vcu >= NU) { ATT_WAIT_BAR(); return; }
    int wl = w; asm volatile("" : "+s"(wl));
    const int lane = fresh_lane(), r32 = lane & 31, hi = lane >> 5, tid = wl * 64 + lane;
    const int c0 = 16 * (wl & 3), c = c0 + (r32 & 15);
    int kstart = c0 - 8; kstart = kstart < 0 ? 0 : (kstart > 32 ? 32 : kstart);
    int cs = c - 8; cs = cs < 0 ? 0 : (cs > 48 ? 48 : cs);
    const int dl = kstart + 4 * hi - cs;
    int cmi[16];
#pragma unroll
    for (int i = 0; i < 16; ++i) cmi[i] = ((unsigned)(dl + (i & 3) + 8 * (i >> 2)) < 16u) ? -1 : 0;
    asm volatile("" : "+v"(cmi[0]), "+v"(cmi[1]), "+v"(cmi[2]), "+v"(cmi[3]), "+v"(cmi[4]), "+v"(cmi[5]), "+v"(cmi[6]), "+v"(cmi[7]));
    asm volatile("" : "+v"(cmi[8]), "+v"(cmi[9]), "+v"(cmi[10]), "+v"(cmi[11]), "+v"(cmi[12]), "+v"(cmi[13]), "+v"(cmi[14]), "+v"(cmi[15]));
    const int opr = wl < 4 ? 2 : 1;
    const unsigned kvo = (unsigned)(16 * (wl & 3) + (lane >> 2)) * 1024u + (unsigned)(((lane & 3) ^ ((lane >> 4) & 3)) * 16);
    const int kkey = kstart + r32, kgx = (kkey >> 2) & 3;
    const int ko0 = (kkey >> 4) * 1024 + ((kkey & 15) * 4 + ((hi * 2) ^ kgx)) * 16, ko1 = (kkey >> 4) * 1024 + ((kkey & 15) * 4 + ((hi * 2 + 1) ^ kgx)) * 16;
    const unsigned vvo = (unsigned)(16 * (wl & 3) + (lane >> 2)) * 6144u + (unsigned)(wl >> 2) * 64u + (unsigned)(lane & 3) * 16u;
    const unsigned kdst = lds0 + wl * 1024;
    int va[4];
#pragma unroll
    for (int j = 0; j < 4; ++j) { const int row = kstart + 4 * hi + ((lane & 15) >> 2) + 8 * j; va[j] = (row >> 4) * 1024 + (row & 15) * 64 + ((lane >> 4) & 1) * 32 + (lane & 3) * 8; }
#define NA_GEOM(u_, b_, h_, R0_, klo_, khi_) const int b_ = (u_) >> 8, h_ = ((u_) >> 4) & 15, R0_ = 4 * ((u_) & 15); \
        int klo_ = R0_ - 4; klo_ = klo_ < 0 ? 0 : klo_; int khi_ = R0_ + 3 - 4; khi_ = (khi_ < 0 ? 0 : (khi_ > 56 ? 56 : khi_)) + 7
#define NA_KBASE(b_, h_) (K8 + (size_t)(b_) * SEQ * 1024 + (h_) * 64)
#define NA_VBASE(b_, h_) (QKV + (size_t)(b_) * SEQ * 3072 + 2048 + (h_) * 64)
#define NA_UNI64(p_) ({ const unsigned long long q_ = (unsigned long long)(p_); const unsigned lo_ = (unsigned)__builtin_amdgcn_readfirstlane((int)(unsigned)q_), hi_ = (unsigned)__builtin_amdgcn_readfirstlane((int)(unsigned)(q_ >> 32)); \
        (const GAS void*)(((unsigned long long)hi_ << 32) | lo_); })
#define NA_DMA(kb_, vb_, kr_, gs_) do { const unsigned d_ = (unsigned)__builtin_amdgcn_readfirstlane(kdst + (unsigned)(((gs_) & 3) * 16384)); \
        const GAS void* pv_ = NA_UNI64((vb_) + (size_t)(kr_) * 64 * 3072); \
        if (wl < 4) { const GAS void* pk_ = NA_UNI64((kb_) + (size_t)(kr_) * 64 * 1024); glds16s_2(pk_, kvo, d_, pv_, vvo, d_ + 8192u); } else glds16s(pv_, vvo, d_ + 8192u); } while (0)
#define NA_QPTR(b_, h_, R0_) ((const GAS u32x4*)(Q8 + ((size_t)(b_) * SEQ + ((R0_) + 2 * (wl >> 2) + (r32 >> 4)) * 64 + c) * 1024 + (h_) * 64 + hi * 32))
    int u = F.vcu, gst = 0, h_tbl = -1; bool first = true;
    u32x4 qfa, qfb, qna = {}, qnb = {};
    { NA_GEOM(u, b0_, h0_, R00_, kl0_, kh0_); (void)kh0_;
      for (int idx = tid; idx < 15 * 31; idx += NTHREADS) TBL[idx] = (rpb[h0_ * 465 + idx] - shift) * LOG2E;
      if (tid < 32) TBL[470 + tid] = -1e30f;
      h_tbl = h0_;
      { const GAS u32x4* qp = NA_QPTR(b0_, h0_, R00_); qfa = qp[0]; qfb = qp[1]; }
      asm volatile("" : "+v"(qfa), "+v"(qfb));
      guc_t kb0 = NA_KBASE(b0_, h0_); gcb_t vb0 = NA_VBASE(b0_, h0_);
      NA_DMA(kb0, vb0, kl0_, 0); NA_DMA(kb0, vb0, kl0_ + 1, 1); NA_DMA(kb0, vb0, kl0_ + 2, 2); }
    for (;;) {
        NA_GEOM(u, b, h, R0, kr_lo, kr_hi);
        const int un = u + F.G; const bool has_next = un < NU;
        NA_GEOM(has_next ? un : u, bn, hn, R0n, kn_lo, kn_hi); (void)kn_hi;
        guc_t kbase = NA_KBASE(b, h); guc_t kbasen = NA_KBASE(bn, hn); gcb_t vbase = NA_VBASE(b, h); gcb_t vbasen = NA_VBASE(bn, hn);
        const int r0 = R0 + 2 * (wl >> 2);
        int wlo = r0 - 4; wlo = wlo < 0 ? 0 : (wlo > 56 ? 56 : wlo); int whi = r0 + 1 - 4; whi = (whi < 0 ? 0 : (whi > 56 ? 56 : whi)) + 7;
        const int r = r0 + (r32 >> 4);
        int rs = r - 4; rs = rs < 0 ? 0 : (rs > 56 ? 56 : rs);
        const LAS char* const tb0 = (const LAS char*)TBL + ((7 - r) * 31 + 15 - c + kstart + 4 * hi) * 4;
        const int nst = first ? 0 : 2;
        float l = 0.f; f32x16 o0 = {}, o1 = {};
        for (int kr = kr_lo; kr <= kr_hi; ++kr, ++gst) {
            const int st = kr - kr_lo, slot = (gst & 3) * 16384, rem = kr_hi - kr;
            int allow = 2 * opr;
            if (st <= 2) allow = 2 * opr + nst; else if (st == 5 || st == 6) allow = has_next ? 2 * opr + 2 : 2 * opr;
            if (!has_next) { if (rem == 1) allow = opr; else if (rem == 0) allow = 0; }
            na_wait_bar(allow);
            if (st == 4 && has_next) {
                const GAS u32x4* qp = NA_QPTR(bn, hn, R0n);
                asm volatile("global_load_dwordx4 %0, %2, off\n\tglobal_load_dwordx4 %1, %2, off offset:16" : "=&v"(qna), "=&v"(qnb) : "v"(qp) : "memory"); }
            if (rem >= 3) NA_DMA(kbase, vbase, kr + 3, gst + 3); else if (has_next) NA_DMA(kbasen, vbasen, kn_lo + (2 - rem), gst + 3);
            if (kr >= wlo && kr <= whi) {
                const LAS char* Kb = L0 + slot; const LAS char* Vb = L0 + slot + 8192;
                const bool rowok = (unsigned)(kr - rs) < 8u;
                const LAS char* tb = rowok ? tb0 + kr * 124 : (const LAS char*)(TBL + 470);
                const u32x4 kfa = *(const LAS u32x4*)(Kb + ko0), kfb = *(const LAS u32x4*)(Kb + ko1);
                float tv[16];
#pragma unroll
                for (int i = 0; i < 16; ++i) tv[i] = *(const LAS float*)(tb + ((i & 3) + 8 * (i >> 2)) * 4);
                s16x4 vl[8];
#pragma unroll
                for (int j = 0; j < 4; ++j) { vl[2 * j] = vtr(Vb + va[j]); vl[2 * j + 1] = vtr(Vb + 4096 + va[j]); }
                __builtin_amdgcn_sched_barrier(0);
                f32x16 s0;
#pragma unroll
                for (int i = 0; i < 16; ++i) s0[i] = tv[i];
                { const v8i32 ka8 = (v8i32){(int)kfa.x, (int)kfa.y, (int)kfa.z, (int)kfa.w, (int)kfb.x, (int)kfb.y, (int)kfb.z, (int)kfb.w};
                  const v8i32 qa8 = (v8i32){(int)qfa.x, (int)qfa.y, (int)qfa.z, (int)qfa.w, (int)qfb.x, (int)qfb.y, (int)qfb.z, (int)qfb.w};
                  s0 = __builtin_amdgcn_mfma_scale_f32_32x32x64_f8f6f4(ka8, qa8, s0, 0, 0, 0, 0, 0, 0); }
                __builtin_amdgcn_sched_barrier(0);
                float ls = 0.f;
#pragma unroll
                for (int i = 0; i < 16; ++i) { float p = __builtin_amdgcn_exp2f(s0[i]); p = __builtin_bit_cast(float, __builtin_bit_cast(int, p) & cmi[i]); s0[i] = p; ls += p; }
                l += ls;
                const bf16x8 pa0 = pack8(s0, 0), pa1 = pack8(s0, 1);
                o0 = MFMA32(pa0, __builtin_shufflevector(vl[0], vl[2], 0, 1, 2, 3, 4, 5, 6, 7), o0);
                o1 = MFMA32(pa0, __builtin_shufflevector(vl[1], vl[3], 0, 1, 2, 3, 4, 5, 6, 7), o1);
                o0 = MFMA32(pa1, __builtin_shufflevector(vl[4], vl[6], 0, 1, 2, 3, 4, 5, 6, 7), o0);
                o1 = MFMA32(pa1, __builtin_shufflevector(vl[5], vl[7], 0, 1, 2, 3, 4, 5, 6, 7), o1);
            }
        }
        wsc[hi * 32 + r32] = l;
        asm volatile("s_waitcnt lgkmcnt(0)" ::: "memory");
        LAS unsigned char* stg = (LAS unsigned char*)(L0 + 69632 + w * 4096) + hi * 4 * 64 + r32;
#pragma unroll
        for (int i = 0; i < 16; ++i) { const int q = crow(i, hi); const float rl = __builtin_amdgcn_rcpf(wsc[q] + wsc[32 + q]);
            stg[((i & 3) + 8 * (i >> 2)) * 64] = (unsigned char)(__builtin_amdgcn_cvt_pk_fp8_f32(o0[i] * rl, 0.f, 0, false) & 0xff);
            stg[((i & 3) + 8 * (i >> 2)) * 64 + 32] = (unsigned char)(__builtin_amdgcn_cvt_pk_fp8_f32(o1[i] * rl, 0.f, 0, false) & 0xff); }
        asm volatile("s_waitcnt lgkmcnt(0)" ::: "memory");
        { guc_t ob_ = (guc_t)AO + ((size_t)b * SEQ + r0 * 64 + c0) * 1024 + h * 64;
          const LAS char* sp = L0 + 69632 + w * 4096 + lane * 16;
#pragma unroll
          for (int jj = 0; jj < 2; ++jj) { const u32x4 val = *(const LAS u32x4*)(sp + jj * 1024);
              const unsigned vo = (unsigned)(jj * 64 + (lane >> 2)) * 1024u + (unsigned)(lane & 3) * 16u;
              *(GAS u32x4*)(ob_ + vo) = val; } }
        if (!has_next) break;
        if (hn != h_tbl) {
            ATT_WAIT_BAR();
            for (int idx = tid; idx < 15 * 31; idx += NTHREADS) TBL[idx] = (rpb[hn * 465 + idx] - shift) * LOG2E;
            h_tbl = hn; ATT_WAIT_BAR(); }
        qfa = qna; qfb = qnb;
        u = un; first = false;
    }
#undef NA_GEOM
#undef NA_KBASE
#undef NA_VBASE
#undef NA_UNI64
#undef NA_QPTR
#undef NA_DMA
    ATT_WAIT_BAR();
}

DI int t5_bucket(int rel) { const int n = rel < 0 ? -rel : rel; int bk;
    if (n < 8) bk = n; else bk = 8 + (n >= 12) + (n >= 16) + (n >= 23) + (n >= 32) + (n >= 46) + (n >= 64) + (n >= 91);
    return bk + (rel > 0 ? 16 : 0); }
DI void diff_epilogue(const f32x16 (&oa)[4], const f32x16 (&ob)[4], LAS float* wsc, float lam, float oml, gcf_t subg, LAS char* L0, int w, gb_t AO, size_t tokb, int qw0, int h) {
    const int lane = fresh_lane(), r32 = lane & 31, hi = lane >> 5;
        float sg[4];
#pragma unroll
        for (int db = 0; db < 4; ++db) sg[db] = subg[db * 32 + r32];
        asm volatile("" : "+v"(sg[0]), "+v"(sg[1]), "+v"(sg[2]), "+v"(sg[3]));
#pragma unroll
        for (int db = 0; db < 4; ++db) sg[db] *= oml;
        LAS unsigned char* stg = (LAS unsigned char*)(L0 + w * 8192) + hi * 4 * 128 + r32;
#pragma unroll
        for (int i = 0; i < 16; ++i) { const int qq = crow(i, hi); const float ra = __builtin_amdgcn_rcpf(wsc[qq] + wsc[32 + qq]), rbb = lam * __builtin_amdgcn_rcpf(wsc[64 + qq] + wsc[96 + qq]);
            float v[4]; float ss = 0.f;
#pragma unroll
            for (int db = 0; db < 4; ++db) { v[db] = oa[db][i] * ra - ob[db][i] * rbb; ss += v[db] * v[db]; }
            ss += SWZ_XOR(ss, 1); ss += SWZ_XOR(ss, 2); ss += SWZ_XOR(ss, 4); ss += SWZ_XOR(ss, 8); ss += SWZ_XOR(ss, 16);
            const float rn = rsqrtf(ss * (1.f / 128.f) + RMS_EPS);
#pragma unroll
            for (int db = 0; db < 4; ++db) stg[((i & 3) + 8 * (i >> 2)) * 128 + db * 32] = (unsigned char)(__builtin_amdgcn_cvt_pk_fp8_f32(v[db] * rn * sg[db], 0.f, 0, false) & 0xff);
            __builtin_amdgcn_sched_barrier(0); }
        asm volatile("s_waitcnt lgkmcnt(0)" ::: "memory");
        { guc_t ob_ = (guc_t)AO + (tokb + qw0) * 1024 + h * 128;
          const unsigned vo = (unsigned)(lane >> 3) * 1024u + (unsigned)(lane & 7) * 16u;
          const LAS char* sp = L0 + w * 8192 + lane * 16;
#pragma unroll
          for (int jj = 0; jj < 4; ++jj) { const u32x4 val = *(const LAS u32x4*)(sp + jj * 1024); *(GAS u32x4*)(ob_ + (size_t)jj * 8192 + vo) = val; } }
}
DI void diff_phase(const Frame& F, gcb_t QKV, guc_t Q8, guc_t K8, gcf_t rel_bias, gcf_t qg, gcf_t kg, gcf_t lq1, gcf_t lk1, gcf_t lq2, gcf_t lk2,
                   gcf_t subg, float lambda_init, gb_t AO) {
    const int w = F.wave;
    LAS char* const L0 = (LAS char*)F.lds;
    LAS float* const TBL = (LAS float*)(L0 + ROWS_OFF);
    LAS float* const wsc = (LAS float*)(L0 + ROWS_OFF + 2048) + w * 128;
    const unsigned lds0 = (unsigned)(uintptr_t)L0;
    float shift, lam;
    { const int lane = F.lane;
    float mb = fmaxf(fmaxf(fabsf(rel_bias[lane]), fabsf(rel_bias[64 + lane])), fmaxf(fabsf(rel_bias[128 + lane]), fabsf(rel_bias[192 + lane])));
    shift = uni(8.f * wave_max(fabsf(qg[lane])) * wave_max(fabsf(kg[lane])) + wave_max(mb));
    lam = uni(__expf(wave_sum(lq1[lane] * lk1[lane])) - __expf(wave_sum(lq2[lane] * lk2[lane])) + lambda_init); }
    const float c1 = 0.125f * LOG2E, oml = uni(1.f - lambda_init);
    for (int it = 0;; ++it) {
        const int u = it * F.G + F.vcu; if (u >= BATCH * 8 * 16) break;
        const int b = u >> 7, h = (u >> 4) & 7, qb = u & 15;
        const int lane = fresh_lane(), r32 = lane & 31, hi = lane >> 5, tid = w * 64 + lane;
        const unsigned kvo = (unsigned)(8 * w + (lane >> 3)) * 1024u + (unsigned)(((lane & 7) ^ (((lane >> 4) & 3) | ((w & 1) << 2))) * 16);
        const int kg_ = ((r32 >> 1) & 3) | (((r32 >> 3) & 1) << 2), kxo = (hi * 2) ^ kg_;
        const int ko0 = (r32 >> 3) * 1024 + (r32 & 7) * 128 + (kxo << 4), ko1 = (r32 >> 3) * 1024 + (r32 & 7) * 128 + ((kxo ^ 1) << 4);
        const unsigned vvo = (unsigned)(16 * (w & 3) + (lane >> 2)) * 6144u + (unsigned)(w >> 2) * 64u + (unsigned)(lane & 3) * 16u;
        const unsigned kdst = lds0 + w * 1024, vdst = lds0 + 32768 + (w >> 2) * 8192 + (w & 3) * 1024;
        const size_t tokb = (size_t)b * SEQ; const int qw0 = qb * 256 + 32 * w, q = qw0 + r32;
        ATT_WAIT_BAR();
        TBL[tid] = (rel_bias[t5_bucket(tid - 256) * 8 + h] - shift) * LOG2E;
        const float cbp = uni((rel_bias[31 * 8 + h] - shift) * LOG2E), cbn = uni((rel_bias[15 * 8 + h] - shift) * LOG2E);
        guc_t kbase = K8 + tokb * 1024 + h * 128;
        gcb_t vbase = QKV + tokb * 3072 + 2048 + h * 128;
#define DIFF_DMA_K(t, ks_) do { kptr += 128 * 1024; const unsigned d_ = (unsigned)__builtin_amdgcn_readfirstlane(kdst + (ks_)); glds16s_2(kptr, kvo, d_, kptr, kvo + 65536u, d_ + 8192u); } while (0)
#define DIFF_DMA_V(t, vs_) do { vptr += 128 * 3072; const unsigned d_ = (unsigned)__builtin_amdgcn_readfirstlane(vdst + (vs_)); glds16s_pair(vptr, vvo, d_, d_ + (16384u - 128u)); \
            glds16s_pair(vptr, vvo + 64u * 6144u, d_ + 4096u, d_ + 4096u + (16384u - 128u)); } while (0)
        guc_t kptr = kbase - 128 * 1024; gcb_t vptr = vbase - 128 * 3072;
        DIFF_DMA_K(0, 0); DIFF_DMA_V(0, 0);
        v8i32 qa8[2];
        { const GAS u32x4* qp = (const GAS u32x4*)(Q8 + (tokb + q) * 1024 + h * 128 + hi * 32);
#pragma unroll
          for (int cc = 0; cc < 2; ++cc) { const u32x4 x0 = qp[cc * 4], x1 = qp[cc * 4 + 1];
              qa8[cc] = (v8i32){(int)x0.x, (int)x0.y, (int)x0.z, (int)x0.w, (int)x1.x, (int)x1.y, (int)x1.z, (int)x1.w}; }
          asm volatile("" : "+v"(qa8[0]), "+v"(qa8[1])); }
        float l0 = 0.f, l1 = 0.f; f32x16 oa[4] = {}, ob[4] = {};
        const int vlane = (4 * hi + ((lane & 15) >> 2)) * 64 + ((lane >> 4) & 1) * 32 + (lane & 3) * 8;
        int vs_cur = 0, vs_prev = 0;
#define SB_ __builtin_amdgcn_sched_barrier(0)
#define LDK8(c, b_, hf) (*(const LAS u32x4*)(Kb + (hf) * 4096 + (((b_) ? ko1 : ko0) ^ ((c) * 64))))
#define LDV(VB, j, db, ks) do { vlo[j] = vtr((VB) + (db) * 8192 + (ks) * 1024); vhi[j] = vtr((VB) + (db) * 8192 + (ks) * 1024 + 512); } while (0)
#define EL_B(LS, e, B) do { const float p_ = __builtin_amdgcn_exp2f(sc[e] * c1 + (B)); sc[e] = p_; LS += p_; } while (0)
#define NEAR_B(R, e, KOFF) (TBL[(R) + ((KOFF) + ((e) & 3) + 8 * ((e) >> 2))])
#define NEAR_LD(p) do { tbv_[2 * (p)] = tbn_[((2 * (p)) & 3) + 8 * ((2 * (p)) >> 2)]; tbv_[2 * (p) + 1] = tbn_[((2 * (p) + 1) & 3) + 8 * ((2 * (p) + 1) >> 2)]; } while (0)
#define MIXSTEP(VB, KS0, i, OACC, LS, NEAR, KOFF, PF, NC, NHF) do { if ((i) + 2 < 8) LDV(VB, (i) + 2, ((i) + 2) >> 1, (KS0) + (((i) + 2) & 1)); \
            if (PF) { if ((i) == 0) kn0 = LDK8(NC, 0, NHF); else if ((i) == 1) kn1 = LDK8(NC, 1, NHF); } \
            { const bf16x8 vf = __builtin_shufflevector(vlo[i], vhi[i], 0, 1, 2, 3, 4, 5, 6, 7); OACC[(i) >> 1] = MFMA32(((i) & 1) ? pp1 : pp0, vf, OACC[(i) >> 1]); } \
            { float x0_ = sc[2 * (i)], x1_ = sc[2 * (i) + 1]; \
              asm volatile("v_exp_f32 %0, %0\n\tv_exp_f32 %1, %1\n\tv_add_f32 %2, %2, %0\n\tv_add_f32 %2, %2, %1" : "+v"(x0_), "+v"(x1_), "+v"(LS)); \
              sc[2 * (i)] = x0_; sc[2 * (i) + 1] = x1_; } \
            SB_; } while (0)
#define HALFROUND(C, NEAR, HF, VB, KS0, OPREV, LS, PF, NC, NHF) do { \
            f32x16 sc = {}; \
            if (NEAR) { const int l_ = fresh_lane(); const LAS float* tbn_ = TBL + (4 * (l_ >> 5) - (l_ & 31) + (rbt - qw0) + 32 * (HF));     \
                _Pragma("unroll") for (int e = 0; e < 16; ++e) sc[e] = tbn_[(e & 3) + 8 * (e >> 2)]; }                                             \
            LDV(VB, 0, 0, (KS0)); LDV(VB, 1, 0, (KS0) + 1); \
            bf16x8 pp0, pp1; \
            if (NEAR) { pp0 = pack8(scp, 0); pp1 = pack8(scp, 1); SB_; }     \
            { const v8i32 ka8 = (v8i32){(int)kn0.x, (int)kn0.y, (int)kn0.z, (int)kn0.w, (int)kn1.x, (int)kn1.y, (int)kn1.z, (int)kn1.w}; \
              sc = __builtin_amdgcn_mfma_scale_f32_32x32x64_f8f6f4(ka8, qa8[C], sc, 0, 0, 0, 0, 0, 0); } \
            SB_; \
            if (!(NEAR)) { pp0 = pack8(scp, 0); pp1 = pack8(scp, 1); }     \
            SB_; \
            MIXSTEP(VB, KS0, 0, OPREV, LS, NEAR, 32 * (HF), PF, NC, NHF); MIXSTEP(VB, KS0, 1, OPREV, LS, NEAR, 32 * (HF), PF, NC, NHF); MIXSTEP(VB, KS0, 2, OPREV, LS, NEAR, 32 * (HF), PF, NC, NHF); MIXSTEP(VB, KS0, 3, OPREV, LS, NEAR, 32 * (HF), PF, NC, NHF); \
            MIXSTEP(VB, KS0, 4, OPREV, LS, NEAR, 32 * (HF), PF, NC, NHF); MIXSTEP(VB, KS0, 5, OPREV, LS, NEAR, 32 * (HF), PF, NC, NHF); MIXSTEP(VB, KS0, 6, OPREV, LS, NEAR, 32 * (HF), PF, NC, NHF); MIXSTEP(VB, KS0, 7, OPREV, LS, NEAR, 32 * (HF), PF, NC, NHF); \
            scp = sc; \
            SB_; } while (0)
#define TILE(NEAR) do { \
            HALFROUND(0, NEAR, 0, Vp, 6, ob, l0, 1, 0, 1); \
            if (t < 31) DIFF_DMA_K(t + 1, 16384 - kslot); \
            HALFROUND(0, NEAR, 1, Vb, 0, oa, l0, 1, 0, 2); \
            if (t < 31) DIFF_DMA_V(t + 1, vsn_); \
            HALFROUND(0, NEAR, 2, Vb, 2, oa, l0, 1, 0, 3); \
            HALFROUND(0, NEAR, 3, Vb, 4, oa, l0, 1, 1, 0); \
            HALFROUND(1, NEAR, 0, Vb, 6, oa, l1, 1, 1, 1); \
            HALFROUND(1, NEAR, 1, Vb, 0, ob, l1, 1, 1, 2); \
            HALFROUND(1, NEAR, 2, Vb, 2, ob, l1, 1, 1, 3); \
            HALFROUND(1, NEAR, 3, Vb, 4, ob, l1, 0, 0, 0); } while (0)
        f32x16 scp = {};
        s16x4 vlo[8], vhi[8];
        int tn0 = (qw0 - 218) >> 7; tn0 = tn0 < -1 ? 0 : tn0 + 1; int tn1 = (qw0 + 122 + 127) >> 7; tn1 = tn1 > 32 ? 32 : tn1;
#define TILE_LOOP(T0, T1, NEAR) for (int t = (T0); t < (T1); ++t) { \
            const int kslot = (t & 1) * 16384; int vsn_ = 0; \
            ATT_WAIT_BAR(); \
            { if (t > 0) { vs_prev = vs_cur; vs_cur = vs_cur + 32768; vs_cur = vs_cur >= 98304 ? 0 : vs_cur; } \
              int vs_next = vs_cur + 32768; vs_next = vs_next >= 98304 ? 0 : vs_next; vsn_ = vs_next; } \
            const LAS char* Kb = L0 + kslot; const LAS char* Vb = L0 + 32768 + vs_cur + vlane; const LAS char* Vp = L0 + 32768 + vs_prev + vlane; \
            const int rbt = 128 * t + 256; \
            u32x4 kn0 = LDK8(0, 0, 0), kn1 = LDK8(0, 1, 0); \
            SB_; \
            TILE(NEAR); }
#define PV_DRAIN() do { const LAS char* Vd_ = L0 + 32768 + vs_cur + vlane; LDV(Vd_, 0, 0, 6); LDV(Vd_, 1, 0, 7); \
            const bf16x8 pp0 = pack8(scp, 0), pp1 = pack8(scp, 1); \
            _Pragma("unroll") for (int i = 0; i < 8; ++i) { if (i + 2 < 8) LDV(Vd_, i + 2, (i + 2) >> 1, 6 + ((i + 2) & 1)); \
                const bf16x8 vf = __builtin_shufflevector(vlo[i], vhi[i], 0, 1, 2, 3, 4, 5, 6, 7); \
                ob[i >> 1] = MFMA32((i & 1) ? pp1 : pp0, vf, ob[i >> 1]); SB_; } \
            scp = (f32x16){}; } while (0)
#define OL_SCALE(f) do { const float f_ = (f); l0 *= f_; l1 *= f_; _Pragma("unroll") for (int db = 0; db < 4; ++db) { oa[db] *= f_; ob[db] *= f_; } } while (0)
        TILE_LOOP(0, tn0, false)
        if (tn0 > 0) { PV_DRAIN(); OL_SCALE(__builtin_amdgcn_exp2f(cbn)); }
        TILE_LOOP(tn0, tn1, true)
        PV_DRAIN(); OL_SCALE(__builtin_amdgcn_exp2f(-cbp));
        TILE_LOOP(tn1, 32, false)
        if (tn1 < 32) PV_DRAIN();
#undef OL_SCALE
#undef PV_DRAIN
#undef TILE_LOOP
#undef TILE
#undef HALFROUND
#undef MIXSTEP
#undef NEAR_LD
#undef NEAR_B
#undef EL_B
#undef LDV
#undef LDK8
#undef SB_
#undef DIFF_DMA_K
#undef DIFF_DMA_V
        { const int fl_ = fresh_lane() & 63; wsc[fl_] = l0; wsc[64 + fl_] = l1; }
        ATT_WAIT_BAR();
        diff_epilogue(oa, ob, wsc, lam, oml, subg, L0, w, AO, tokb, qw0, h);
    }
    ATT_WAIT_BAR();
}

typedef float f32x4v __attribute__((ext_vector_type(4)));
DI void router_phase(const Frame& F, gcb_t x, gcf_t g, gcf_t wg, gcf_t bg, gcf_t we, gcf_t be, gf_t rs2, TokG T, gu_t cnt) {
    const int lane = F.lane, n16 = lane & 15, kq = lane >> 4, w = F.wave;
    LAS float* const WL = (LAS float*)F.lds;
    LAS float* const scr = (LAS float*)(F.lds + 131072) + w * 512;
    __syncthreads();
    {
        f32x4 cw[2][5]; float gk[2];
#pragma unroll
        for (int rr = 0; rr < 2; ++rr) { const int k = F.tid + rr * NTHREADS; gk[rr] = g[k]; cw[rr][0] = ((const GAS f32x4*)wg)[k];
#pragma unroll
            for (int q = 0; q < 4; ++q) cw[rr][1 + q] = ((const GAS f32x4*)we)[k * 4 + q]; }
        LAS unsigned short* const WH = (LAS unsigned short*)F.lds; LAS unsigned short* const WLo = (LAS unsigned short*)(F.lds + 65536);
#pragma unroll
        for (int rr = 0; rr < 2; ++rr) { const int k = F.tid + rr * NTHREADS, Tt = k >> 5, kq_ = (k >> 3) & 3, j = k & 7;
#pragma unroll
            for (int c = 0; c < 32; ++c) { const int oh = c >> 4, n = c & 15; const int idx = (((Tt * 2 + oh) * 4 + kq_) * 16 + n) * 8 + j;
                unsigned short hb = 0, lb = 0;
                if (c < 20) { const float wv = cw[rr][c >> 2][c & 3] * gk[rr]; hb = (unsigned short)f2bf(wv); lb = (unsigned short)f2bf(wv - bf2f(hb)); }
                WH[idx] = hb; WLo[idx] = lb; } }
    }
    if (F.tid < 16) F.MISC[64 + F.tid] = 0u;
    __syncthreads();
    const LAS char* const Wb = (const LAS char*)F.lds + lane * 16;
    const int gw = F.vcu * NWAVES + F.wave, NGW = F.G * NWAVES;
    float bgv[4], bev[16];
#pragma unroll
    for (int i = 0; i < 4; ++i) bgv[i] = bg[i];
#pragma unroll
    for (int i = 0; i < 16; ++i) bev[i] = be[i];
    asm volatile("" : "+v"(bgv[0]), "+v"(bgv[1]), "+v"(bgv[2]), "+v"(bgv[3]));
    asm volatile("" : "+v"(bev[0]), "+v"(bev[1]), "+v"(bev[2]), "+v"(bev[3]), "+v"(bev[4]), "+v"(bev[5]), "+v"(bev[6]), "+v"(bev[7]));
    asm volatile("" : "+v"(bev[8]), "+v"(bev[9]), "+v"(bev[10]), "+v"(bev[11]), "+v"(bev[12]), "+v"(bev[13]), "+v"(bev[14]), "+v"(bev[15]));
    for (int task = gw; task < M / 16; task += NGW) {
        const int tok0 = task * 16;
        const GAS u32x4* xr = (const GAS u32x4*)(x + (size_t)(tok0 + n16) * D) + kq;
        f32x4v a0 = {0.f, 0.f, 0.f, 0.f}, a1 = {0.f, 0.f, 0.f, 0.f}; float ssq = 0.f;
        u32x4 rr_[32];
#pragma unroll
        for (int Tt = 0; Tt < 32; ++Tt) rr_[Tt] = xr[4 * Tt];
#pragma unroll
        for (int Tt = 0; Tt < 32; ++Tt) {
            const u32x4 r_ = rr_[Tt];
            float xv[8];
#pragma unroll
            for (int e = 0; e < 4; ++e) { xv[2 * e] = bf2f((unsigned short)(r_[e] & 0xffffu)); xv[2 * e + 1] = bf2f((unsigned short)(r_[e] >> 16)); }
#pragma unroll
            for (int e = 0; e < 8; ++e) ssq += xv[e] * xv[e];
            const bf16x8 av = __builtin_bit_cast(bf16x8, r_);
            const bf16x8 bh0 = *(const LAS bf16x8*)(Wb + (Tt * 2) * 1024), bh1 = *(const LAS bf16x8*)(Wb + (Tt * 2 + 1) * 1024);
            const bf16x8 bl0 = *(const LAS bf16x8*)(Wb + 65536 + (Tt * 2) * 1024), bl1 = *(const LAS bf16x8*)(Wb + 65536 + (Tt * 2 + 1) * 1024);
            a0 = __builtin_amdgcn_mfma_f32_16x16x32_bf16(av, bh0, a0, 0, 0, 0); a0 = __builtin_amdgcn_mfma_f32_16x16x32_bf16(av, bl0, a0, 0, 0, 0);
            a1 = __builtin_amdgcn_mfma_f32_16x16x32_bf16(av, bh1, a1, 0, 0, 0); a1 = __builtin_amdgcn_mfma_f32_16x16x32_bf16(av, bl1, a1, 0, 0, 0);
        }
#pragma unroll
        for (int r = 0; r < 4; ++r) { scr[(4 * kq + r) * 32 + n16] = a0[r]; scr[(4 * kq + r) * 32 + 16 + n16] = a1[r]; }
        asm volatile("s_waitcnt lgkmcnt(0)" ::: "memory");
        scr[n16 * 32 + 20 + kq] = ssq;
        asm volatile("s_waitcnt lgkmcnt(0)" ::: "memory");
        float rstd = 0.f;
        if (lane < 16) {
            float lg[24];
#pragma unroll
            for (int q4 = 0; q4 < 6; ++q4) { const f32x4v t4 = *(const LAS f32x4v*)(scr + lane * 32 + 4 * q4); lg[4 * q4] = t4[0]; lg[4 * q4 + 1] = t4[1]; lg[4 * q4 + 2] = t4[2]; lg[4 * q4 + 3] = t4[3]; }
            rstd = rsqrtf(((lg[20] + lg[21]) + (lg[22] + lg[23])) * (1.f / D) + RMS_EPS);
            const int tok = tok0 + lane;
            rs2[tok] = rstd;
            float gl[4]; int gi = 0; float gm = -1e30f;
#pragma unroll
            for (int i = 0; i < 4; ++i) { gl[i] = lg[i] * rstd + bgv[i]; if (gl[i] > gm) { gm = gl[i]; gi = i; } }
            float gs = 0.f;
#pragma unroll
            for (int i = 0; i < 4; ++i) gs += __expf(gl[i] - gm);
            const float gp = 1.f / gs;
            float el[4];
#pragma unroll
            for (int i = 0; i < 4; ++i) { float t = 0.f;
#pragma unroll
                for (int gq = 0; gq < 4; ++gq) t = (gq == gi) ? (lg[4 + gq * 4 + i] * rstd + bev[gq * 4 + i]) : t;
                el[i] = t; }
            int i0 = 0; float m0 = el[0];
#pragma unroll
            for (int i = 1; i < 4; ++i) if (el[i] > m0) { m0 = el[i]; i0 = i; }
            int i1 = -1; float m1 = -1e30f;
#pragma unroll
            for (int i = 0; i < 4; ++i) if (i != i0 && el[i] > m1) { m1 = el[i]; i1 = i; }
            const float e1 = __expf(m1 - m0), w0 = gp / (1.f + e1), w1 = gp * e1 / (1.f + e1);
            const int E0 = gi * 4 + i0, E1 = gi * 4 + i1;
            T.tok_e[tok * 2] = E0; T.tok_e[tok * 2 + 1] = E1; T.tok_w[tok * 2] = w0; T.tok_w[tok * 2 + 1] = w1;
            __hip_atomic_fetch_add((LAS unsigned*)&F.MISC[64 + E0], 1u, __ATOMIC_RELAXED, __HIP_MEMORY_SCOPE_WORKGROUP); __hip_atomic_fetch_add((LAS unsigned*)&F.MISC[64 + E1], 1u, __ATOMIC_RELAXED, __HIP_MEMORY_SCOPE_WORKGROUP);
        }
    }
    __syncthreads();
    { const int t2 = F.wave * 64 + fresh_lane(); if (t2 < 16) { const unsigned c = F.MISC[64 + t2]; if (c) atomicAdd((unsigned*)&cnt[t2], c); } }
}
DI void assign_phase(const Frame& F, gcu_t cnt, gu_t cur, TokG T, gi_t tile_e, gcf_t rs2, gf_t srs) {
    const int lane = F.lane;
    int pst = 0, myc = 0;
    { int acc = 0;
#pragma unroll
      for (int e = 0; e < NE; ++e) { const int c = (int)cnt[e]; if (lane == e) { pst = acc; myc = c; } acc += (c + 255) / 256 * 256; } }
    const unsigned long long ltmask = (1ull << lane) - 1ull;
    if (F.wave < 2) {
        for (int tok = (F.bx * 2 + F.wave) * 64 + lane; tok < M; tok += F.G * 128) {
            const int e0 = T.tok_e[tok * 2], e1 = T.tok_e[tok * 2 + 1]; int r0 = 0, r1 = 0, tot = 0;
#pragma unroll
            for (int ee = 0; ee < NE; ++ee) {
                const unsigned long long m0 = __ballot(e0 == ee), m1 = __ballot(e1 == ee);
                const int n0 = __popcll(m0), n1 = __popcll(m1);
                if (e0 == ee) r0 = __popcll(m0 & ltmask);
                if (e1 == ee) r1 = n0 + __popcll(m1 & ltmask);
                if (lane == ee) tot = n0 + n1;
            }
            int base = pst;
            if (lane < NE && tot > 0) base += (int)atomicAdd((unsigned*)&cur[lane], (unsigned)tot);
            const int s0 = __shfl(base, e0) + r0, s1 = __shfl(base, e1) + r1;
            T.slot_tok[s0] = tok; T.slot_tok[s1] = tok; T.tok_slot[tok * 2] = s0; T.tok_slot[tok * 2 + 1] = s1;
            { const float rv = rs2[tok]; srs[s0] = rv; srs[s1] = rv; }
        }
    }
    if (F.bx == F.G - 1 && F.wave >= 2) {
        for (int e = 0; e < NE; ++e) { const int ps = __shfl(pst, e), pc = __shfl(myc, e); const int padded = (pc + 255) / 256 * 256;
            for (int j2 = pc + (F.tid - 128); j2 < padded; j2 += NTHREADS - 128) { T.slot_tok[ps + j2] = 0; srs[ps + j2] = 0.f; }
            for (int tI = ps / 256 + (F.tid - 128); tI < (ps + padded) / 256; tI += NTHREADS - 128) tile_e[tI] = e; }
        { const int pe = __shfl(pst, NE - 1), ce = __shfl(myc, NE - 1); for (int tI = (pe + (ce + 255) / 256 * 256) / 256 + (F.tid - 128); tI < MAXT + 1; tI += NTHREADS - 128) tile_e[tI] = -1; }
    }
}
DI int moe_setup(const Frame& F, gcu_t cnt, gci_t slot_tok, bool gather) {
    __syncthreads();
    if (F.tid < 64) {
        const int ln = F.tid; int v = ln < NE ? ((int)cnt[ln & (NE - 1)] + 255) / 256 : 0;
#pragma unroll
        for (int d = 1; d < NE; d <<= 1) { const int t = __shfl_up(v, d); if (ln >= d) v += t; }
        if (ln < NE) F.MISC[16 + ln] = (unsigned)v;
        if (ln == NE - 1) F.MISC[32] = (unsigned)v; }
    __syncthreads();
    const int ntiles = (int)F.MISC[32];
    if (gather) { LAS int* rows = (LAS int*)(F.lds + ROWS_OFF);
        int rv[6];
        const int nun_ = ntiles * 4, nfl_ = (nun_ / F.G) * F.G, lft_ = nun_ - nfl_;
        const int Lt_ = 2 * lft_ <= F.G ? ((F.vcu >> 1) < lft_ ? nfl_ + (F.vcu >> 1) : -1) : (nfl_ + F.vcu < nun_ ? nfl_ + F.vcu : -1);
#pragma unroll
        for (int i = 0; i < 6; ++i) { const int L = i < 5 ? (i * F.G + F.vcu < nfl_ ? i * F.G + F.vcu : -1) : Lt_; rv[i] = (L >= 0 && F.tid < 256) ? slot_tok[(L >> 2) * 256 + F.tid] : 0; }
        asm volatile("" : "+v"(rv[0]), "+v"(rv[1]), "+v"(rv[2]), "+v"(rv[3]), "+v"(rv[4]), "+v"(rv[5]));
#pragma unroll
        for (int i = 0; i < 6; ++i) { if (F.tid < 256) rows[i * 256 + F.tid] = rv[i]; }
        __syncthreads(); }
    return ntiles;
}
DI void combine_phase(const Frame& F, gb_t x, gf_t out32, gcb_t Y, TokG T, gf_t rs1) {
    const int lane = F.lane, gw = F.vcu * NWAVES + F.wave, NGW = F.G * NWAVES;
    static_assert(M % (NWAVES * 256) == 0, "tokens per wave");
    const int ntk = M / NGW;
    int sl0 = 0, sl1 = 0; float ww0 = 0.f, ww1 = 0.f;
    if (lane < ntk) { const int tk = gw + NGW * lane; sl0 = T.tok_slot[tk * 2]; sl1 = T.tok_slot[tk * 2 + 1]; ww0 = T.tok_w[tk * 2] * (1.f / 32.f); ww1 = T.tok_w[tk * 2 + 1] * (1.f / 32.f); }
    for (int i0 = 0; i0 < ntk; i0 += 4) {
        u32x4 xa[4][2], ya[4], yb[4];
#pragma unroll
        for (int tt = 0; tt < 4; ++tt) { const int i = i0 + tt, tok = gw + NGW * i;
            const int s0 = __builtin_amdgcn_readlane(sl0, i), s1 = __builtin_amdgcn_readlane(sl1, i);
            const GAS u32x4* xr = (const GAS u32x4*)(x + (size_t)tok * D) + lane * 2;
            const GAS u32x4* y0 = (const GAS u32x4*)((guc_t)Y + (size_t)s0 * D) + lane; const GAS u32x4* y1 = (const GAS u32x4*)((guc_t)Y + (size_t)s1 * D) + lane;
            xa[tt][0] = xr[0]; xa[tt][1] = xr[1]; ya[tt] = y0[0]; yb[tt] = y1[0]; }
#pragma unroll
        for (int tt = 0; tt < 4; ++tt) { const int i = i0 + tt, tok = gw + NGW * i;
            const float w0 = __builtin_bit_cast(float, __builtin_amdgcn_readlane(__builtin_bit_cast(int, ww0), i)), w1 = __builtin_bit_cast(float, __builtin_amdgcn_readlane(__builtin_bit_cast(int, ww1), i));
            float s = 0.f;
#pragma unroll
            for (int hh = 0; hh < 2; ++hh) { float v[8];
#pragma unroll
                for (int e2 = 0; e2 < 2; ++e2) { const int ya_ = (int)ya[tt][2 * hh + e2], yb_ = (int)yb[tt][2 * hh + e2];
                    const auto a0 = __builtin_amdgcn_cvt_pk_f32_fp8(ya_, false), a1 = __builtin_amdgcn_cvt_pk_f32_fp8(ya_, true), b0 = __builtin_amdgcn_cvt_pk_f32_fp8(yb_, false), b1 = __builtin_amdgcn_cvt_pk_f32_fp8(yb_, true);
                    const unsigned c0 = xa[tt][hh][2 * e2], c1 = xa[tt][hh][2 * e2 + 1];
                    v[4 * e2] = bf2f(c0 & 0xffff) + w0 * a0[0] + w1 * b0[0]; v[4 * e2 + 1] = bf2f(c0 >> 16) + w0 * a0[1] + w1 * b0[1];
                    v[4 * e2 + 2] = bf2f(c1 & 0xffff) + w0 * a1[0] + w1 * b1[0]; v[4 * e2 + 3] = bf2f(c1 >> 16) + w0 * a1[1] + w1 * b1[1];
                    s += v[4 * e2] * v[4 * e2] + v[4 * e2 + 1] * v[4 * e2 + 1] + v[4 * e2 + 2] * v[4 * e2 + 2] + v[4 * e2 + 3] * v[4 * e2 + 3]; }
                if (out32) { GAS f32x4* op = (GAS f32x4*)(out32 + (size_t)tok * D) + lane * 4 + hh * 2; op[0] = (f32x4){v[0], v[1], v[2], v[3]}; op[1] = (f32x4){v[4], v[5], v[6], v[7]}; }
                else { u32x4 wv; wv.x = cvtpk(v[0], v[1]); wv.y = cvtpk(v[2], v[3]); wv.z = cvtpk(v[4], v[5]); wv.w = cvtpk(v[6], v[7]); ((GAS u32x4*)(x + (size_t)tok * D) + lane * 2)[hh] = wv; } }
            if (!out32) { const float r = rsqrtf(wave_sum(s) * (1.f / D) + RMS_EPS); if (lane == 0) rs1[tok] = r; } }
    }
}

constexpr int NPHASE = 1 + 8 * DEPTH;
#ifndef PHMASK
#define PHMASK 0x3ff
#endif
#define EN(k) (((PHMASK) >> (k)) & 1)
#ifndef REPMASK
#define REPMASK 0
#endif
#define NREP(k) (1 + (((REPMASK) >> (k)) & 1))
__global__ void __launch_bounds__(NTHREADS, 2) mega(Args a) {
    extern __shared__ __attribute__((aligned(16))) unsigned char lds_raw[];
    Frame F;
    F.lds = (LAS unsigned char*)lds_raw; F.MISC = (volatile LAS unsigned*)(F.lds + MISC_OFF);
    F.tid = threadIdx.x; F.lane = F.tid & 63; F.wave = __builtin_amdgcn_readfirstlane(F.tid >> 6);
    F.G = gridDim.x; F.bx = blockIdx.x; { const int bx = blockIdx.x; F.vcu = (F.G % 8 == 0) ? (bx % 8) * (F.G / 8) + bx / 8 : bx; }
    F.ws = (guc_t)a.ws; F.ctl = (gu_t)(F.ws + WS_CTL);
    for (int u = F.tid; u < 256; u += NTHREADS) F.MISC[u] = 0u;
    __syncthreads();
    const int lo = a.ph_lo, hi = a.ph_hi;
    if (lo >= 100) { Frame FC = F; FC.lane = fresh_lane(); FC.tid = F.wave * 64 + FC.lane; convert_layer(FC, a, lo - 100); return; }
    XcdBarrier bar = xcd_barrier_post((unsigned*)(F.ctl + CW_BAR + lo * XCD_BAR_WORDS), F.MISC + 8, F.wave);
#define IN(k) (lo <= (k) && (k) < hi)
#define SEAM(k) do { if (IN(k) && IN((k) + 1)) xcd_barrier(bar); } while (0)
#define INP(i) ((gcf_t)al.in[i])
#define FRESH(FP) Frame FP = FL; FP.lane = fresh_lane(); FP.tid = FL.wave * 64 + FP.lane

    if (EN(0) && IN(0)) {
        Frame FC = F; FC.lane = fresh_lane(); FC.tid = F.wave * 64 + FC.lane;
        convert_layer(FC, a, 0);
        const int gw = F.vcu * NWAVES + F.wave, NGW = F.G * NWAVES;
        gb_t X0 = (gb_t)(F.ws + WS_X16); gcf_t x0 = (gcf_t)a.in[0]; gf_t rs0 = (gf_t)(F.ws + WS_TOK + 1536 * 1024);
        {
            f32x4 ra[4], rb[4]; int m = gw;
            if (m < M) stream_load(x0 + (size_t)m * D, ra, FC.lane);
            for (; m < M; m += 2 * NGW) {
                const bool hb = m + NGW < M;
                if (hb) stream_load(x0 + (size_t)(m + NGW) * D, rb, FC.lane);
                stream_store(ra, X0 + (size_t)m * D, rs0 + m, FC.lane);
                if (!hb) break;
                const bool ha = m + 2 * NGW < M;
                if (ha) stream_load(x0 + (size_t)(m + 2 * NGW) * D, ra, FC.lane);
                stream_store(rb, X0 + (size_t)(m + NGW) * D, rs0 + m + NGW, FC.lane);
                if (!ha) break;
            }
        }
    }
    SEAM(0);
    for (int L = 0; L < DEPTH; ++L) {
        const int pb = 1 + 8 * L, j = L >> 1; const bool is_na = !(L & 1);
        Frame FL = F; int bxL = (int)blockIdx.x; asm volatile("" : "+s"(FL.vcu), "+s"(FL.G), "+s"(bxL)); FL.bx = bxL;
        guc_t wsL = F.ws; gf_t out = (gf_t)a.out; asm volatile("" : "+s"(wsL), "+s"(out));
        Args al = a;
#pragma unroll
        for (int i = 0; i < 25; ++i) asm volatile("" : "+s"(al.in[i]));
        gb_t Wqkvp = (gb_t)(wsL + WS_WQKVP); gb_t Wo_t = (gb_t)(wsL + WS_WO); gb_t Wgu_t = (gb_t)(wsL + WS_WGU); gb_t Wd_t = (gb_t)(wsL + WS_WD);
        gf_t RS1 = (gf_t)(wsL + WS_TOK + 1536 * 1024), RS2 = (gf_t)(wsL + WS_TOK + 1792 * 1024), SRS = (gf_t)(wsL + WS_TOK + 2048 * 1024);
        gb_t QKV = (gb_t)(wsL + WS_QKV); gb_t AO = (gb_t)(wsL + WS_AO); gb_t Hb = (gb_t)(wsL + WS_H); gb_t Yb = (gb_t)(wsL + WS_Y);
        TokG T; T.tok_e = (gi_t)(wsL + WS_TOK); T.tok_w = (gf_t)(wsL + WS_TOK + 256 * 1024); T.tok_slot = (gi_t)(wsL + WS_TOK + 512 * 1024); T.slot_tok = (gi_t)(wsL + WS_TOK + 768 * 1024);
        gi_t tile_e = (gi_t)(wsL + WS_TOK + 768 * 1024 + 512 * 1024); gb_t X16 = (gb_t)(wsL + WS_X16);
        if (EN(1) && IN(pb)) for (int rep_ = 0; rep_ < NREP(1); ++rep_) { FRESH(FP);
            pg8::DenseOrder S; S.init(M, 3072, 1024, FL.G, bxL, (gcc_t)X16, (gcc_t)Wqkvp);
            pg8::EpiQKV E{QKV, (is_na ? INP(5) : INP(10)) + j * 64, (is_na ? INP(6) : INP(11)) + j * 64, (gcf_t)RS1, 0.125f * LOG2E, (guc_t)(wsL + WS_XN), (guc_t)(wsL + WS_XN + 32 * MiB)};
            pg8::gemm_phase<pg8::EpiQKV, pg8::DenseOrder, false>(FP.tid, FP.lds, 1024, S, E, nullptr);
        }
        SEAM(pb);
        if (IN(pb + 1)) {
            if (!EN(3) || (EN(2) && is_na)) { if (EN(2)) for (int rep_ = 0; rep_ < NREP(2); ++rep_) { FRESH(FP); na_phase(FP, QKV, (guc_t)(wsL + WS_XN), (guc_t)(wsL + WS_XN + 32 * MiB), INP(7) + (size_t)j * 16 * 465, INP(5) + j * 64, INP(6) + j * 64, AO); } }
            else for (int rep_ = 0; rep_ < NREP(3); ++rep_) { FRESH(FP); diff_phase(FP, QKV, (guc_t)(wsL + WS_XN), (guc_t)(wsL + WS_XN + 32 * MiB), INP(17), INP(10) + j * 64, INP(11) + j * 64, INP(12) + j * 64, INP(13) + j * 64, INP(14) + j * 64, INP(15) + j * 64, INP(16) + j * 128,
                            0.8f - 0.6f * __expf(-0.3f * (float)L), AO); }
        }
        SEAM(pb + 1);
        if (EN(4) && IN(pb + 2)) { FRESH(FP);
            pg8::DenseOrder S; S.init(M, 1024, 512, FL.G, bxL, (gcc_t)AO, (gcc_t)Wo_t);
            pg8::EpiRes<true> E{INP(0), (gcb_t)X16, X16, (guc_t)(wsL + WS_AO + 32 * MiB)}; pg8::gemm_phase<pg8::EpiRes<true>, pg8::DenseOrder, false, true>(FP.tid, FP.lds, 512, S, E, nullptr);
        }
        SEAM(pb + 2);
        gu_t cnt = (gu_t)(wsL + WS_CTL) + CW_CNT + L * 16; gu_t cur = (gu_t)(wsL + WS_CTL) + CW_CUR + L * 16;
        if (EN(5) && IN(pb + 3)) { FRESH(FP); router_phase(FP, (gcb_t)X16, INP(2) + L * 1024, INP(18) + (size_t)L * 1024 * 4, INP(19) + L * 4, INP(20) + (size_t)L * 1024 * 16, INP(21) + L * 16, RS2, T, cnt); }
        SEAM(pb + 3);
        if (EN(6) && IN(pb + 4)) { FRESH(FP); assign_phase(FP, cnt, cur, T, tile_e, (gcf_t)RS2, SRS); }
        SEAM(pb + 4);
        if (EN(7) && IN(pb + 5)) for (int rep_ = 0; rep_ < NREP(7); ++rep_) { FRESH(FP);
            const int ntiles = moe_setup(FP, cnt, T.slot_tok, true);
            pg8::MoeOrder S{ntiles * 4, FL.G, FL.vcu, 512, (gcc_t)(wsL + WS_AO + 32 * MiB), (gcc_t)Wgu_t, (size_t)1024 * 1024 * 2, (const LAS int*)(FP.lds + MISC_OFF + 64), true, 0};
            pg8::EpiGateUp E{Hb, (gcf_t)SRS};
            pg8::gemm_phase<pg8::EpiGateUp, pg8::MoeOrder, true, true>(FP.tid, FP.lds, 512, S, E, (const LAS int*)(FP.lds + ROWS_OFF));
            { const int left_ = ntiles * 4 - (ntiles * 4 / FL.G) * FL.G;
              if (left_ > 0) { __syncthreads();
                  if (2 * left_ <= FL.G) { S.mode = 1; pg8::gemm_phase<pg8::EpiGateUp, pg8::MoeOrder, true, true, true>(FP.tid, FP.lds, 512, S, E, (const LAS int*)(FP.lds + ROWS_OFF) + 5 * 256); }
                  else { S.mode = 2; pg8::gemm_phase<pg8::EpiGateUp, pg8::MoeOrder, true, true>(FP.tid, FP.lds, 512, S, E, (const LAS int*)(FP.lds + ROWS_OFF) + 5 * 256); } } }
        }
        SEAM(pb + 5);
        if (EN(8) && IN(pb + 6)) for (int rep_ = 0; rep_ < NREP(8); ++rep_) { FRESH(FP);
            const int ntiles = moe_setup(FP, cnt, T.slot_tok, false);
            pg8::MoeOrder S{ntiles * 4, FL.G, FL.vcu, 256, (gcc_t)Hb, (gcc_t)Wd_t, (size_t)1024 * 512 * 2, (const LAS int*)(FP.lds + MISC_OFF + 64), false, 0};
            pg8::EpiY8 E{(guc_t)Yb, 1024};
            pg8::gemm_phase<pg8::EpiY8, pg8::MoeOrder, false, true>(FP.tid, FP.lds, 256, S, E, nullptr);
            { const int left_ = ntiles * 4 - (ntiles * 4 / FL.G) * FL.G;
              if (left_ > 0) { __syncthreads();
                  if (2 * left_ <= FL.G) { S.mode = 1; pg8::gemm_phase<pg8::EpiY8, pg8::MoeOrder, false, true, true>(FP.tid, FP.lds, 256, S, E, nullptr); }
                  else { S.mode = 2; pg8::gemm_phase<pg8::EpiY8, pg8::MoeOrder, false, true>(FP.tid, FP.lds, 256, S, E, nullptr); } } }
        }
        SEAM(pb + 6);
        if (EN(9) && IN(pb + 7)) { FRESH(FP);
            if (L + 1 < DEPTH) convert_layer(FP, al, L + 1);
            combine_phase(FP, X16, L + 1 < DEPTH ? (gf_t)nullptr : out, Yb, T, RS1);
        }
        SEAM(pb + 7);
    }
#undef IN
#undef SEAM
#undef INP
#undef FRESH
}


#ifndef MK_MODE
#define MK_MODE 1
#endif
#ifndef NEWMASK
#define NEWMASK 0x3ff
#endif
extern "C" void kernel_launch(void* const* d_in, const int* in_sizes, int n_in, void* d_out, int out_size, void* d_ws, size_t ws_size, hipStream_t stream) {
    if (n_in != 25 || ws_size < WS_END2) { fprintf(stderr, "kernel_launch: unexpected n_in %d / ws %zu\n", n_in, ws_size); return; }
    static int grid = 0;
    if (grid == 0) {
        int dev = 0, cus = 0;
        if (hipGetDevice(&dev) != hipSuccess || hipDeviceGetAttribute(&cus, hipDeviceAttributeMultiprocessorCount, dev) != hipSuccess) { grid = -1; return; }
        if (hipFuncSetAttribute((const void*)mega, hipFuncAttributeMaxDynamicSharedMemorySize, LDS_BYTES) != hipSuccess) { grid = -1; return; }
        int per_cu = 0;
        if (hipOccupancyMaxActiveBlocksPerMultiprocessor(&per_cu, (const void*)mega, NTHREADS, LDS_BYTES) != hipSuccess || per_cu < 1) { fprintf(stderr, "kernel_launch: occupancy query says %d\n", per_cu); }
        (void)hipGetLastError();
        grid = cus;
    }
    if (grid < 0) return;
    const float* x = (const float*)d_in[0];
    const float* mix_g = (const float*)d_in[1]; const float* ffn_g = (const float*)d_in[2];
    const float* na_wqkv = (const float*)d_in[3]; const float* na_wo = (const float*)d_in[4]; const float* na_qg = (const float*)d_in[5]; const float* na_kg = (const float*)d_in[6]; const float* na_rpb = (const float*)d_in[7];
    const float* df_wqkv = (const float*)d_in[8]; const float* df_wo = (const float*)d_in[9]; const float* df_qg = (const float*)d_in[10]; const float* df_kg = (const float*)d_in[11];
    const float* lq1 = (const float*)d_in[12]; const float* lk1 = (const float*)d_in[13]; const float* lq2 = (const float*)d_in[14]; const float* lk2 = (const float*)d_in[15];
    const float* subg = (const float*)d_in[16]; const float* rel_bias = (const float*)d_in[17];
    const float* rgw = (const float*)d_in[18]; const float* rgb = (const float*)d_in[19]; const float* rew = (const float*)d_in[20]; const float* reb = (const float*)d_in[21];
    float* out = (float*)d_out; unsigned char* ws = (unsigned char*)d_ws;
    unsigned* ctl = (unsigned*)(ws + WS_CTL);
    bf16_t* Wqkv_t = (bf16_t*)(ws + WS_WQKV); bf16_t* Wo_t = (bf16_t*)(ws + WS_WO); bf16_t* Wgu_t = (bf16_t*)(ws + WS_WGU); bf16_t* Wd_t = (bf16_t*)(ws + WS_WD);
    bf16_t* XN = (bf16_t*)(ws + WS_XN); bf16_t* QKV = (bf16_t*)(ws + WS_QKV); bf16_t* AO = (bf16_t*)(ws + WS_AO); bf16_t* Hb = (bf16_t*)(ws + WS_H); bf16_t* Yb = (bf16_t*)(ws + WS_Y);
    TokArrays T; T.tok_e = (int*)(ws + WS_TOK); T.tok_w = (float*)(ws + WS_TOK + 256 * 1024); T.tok_slot = (int*)(ws + WS_TOK + 512 * 1024); T.slot_tok = (int*)(ws + WS_TOK + 768 * 1024);
    int* tile_e = (int*)(ws + WS_TOK + 768 * 1024 + 512 * 1024);
    float* tbl = (float*)(ws + WS_TBL); float* lamp = (float*)(ws + WS_TBL + 512 * 1024);
    const int BIG = 1 << 30;

    (void)hipMemsetAsync(ws + WS_CTL, 0, 1 * MiB, stream);
    Args a{};
    for (int i = 0; i < 25; ++i) a.in[i] = (const float*)d_in[i];
    a.out = out; a.ws = ws;
#ifndef HOSTREP
#define HOSTREP 0
#endif
#define LAUNCH_MEGA(lo_, hi_) do { a.ph_lo = (lo_); a.ph_hi = (hi_); hipLaunchKernelGGL(mega, dim3(grid), dim3(NTHREADS), LDS_BYTES, stream, a); } while (0)
    if (MK_MODE == 1) { LAUNCH_MEGA(0, NPHASE); return; }
    const unsigned nm = NEWMASK;
    for (int L = 0; L < DEPTH; ++L) {
        const int j = L / 2, pb = 1 + 8 * L; const bool is_na = (L % 2 == 0);
        const float* wqkv = (is_na ? na_wqkv : df_wqkv) + (size_t)j * 1024 * 3072;
        if (nm != 0x3ffu) {
            LAUNCH_MEGA(100 + L, 101 + L);
            k_transpose<<<dim3(3072 / 32, 1024 / 32, 1), 256, 0, stream>>>(wqkv, Wqkv_t, 1024, 3072, BIG, 0, 0, 0, 0, 0);
        }
        if (L == 0) { if (nm & 1u) { LAUNCH_MEGA(0, 1); if (HOSTREP & 1) LAUNCH_MEGA(0, 1); } else k_rmsnorm<<<M / 4, 256, 0, stream>>>(x, mix_g, XN); }
        if (nm & 2u) { LAUNCH_MEGA(pb, pb + 1); if (HOSTREP & 2) LAUNCH_MEGA(pb, pb + 1); }
        else { k_gemm<EpiStoreBf16><<<dim3(3072 / 128, M / 128), 256, 0, stream>>>(XN, Wqkv_t, 1024, 1024, 1024, 0, EpiStoreBf16{QKV, 3072, 0});
               k_qknorm<<<M / 4, 256, 0, stream>>>(QKV, (is_na ? na_qg : df_qg) + j * 64, (is_na ? na_kg : df_kg) + j * 64); }
        if (is_na) { if (nm & 4u) { LAUNCH_MEGA(pb + 1, pb + 2); if (HOSTREP & 4) LAUNCH_MEGA(pb + 1, pb + 2); } else k_na_attn<<<M / 4, 256, 0, stream>>>(QKV, na_rpb + (size_t)j * 16 * 15 * 31, AO); }
        else { if (nm & 8u) { LAUNCH_MEGA(pb + 1, pb + 2); if (HOSTREP & 8) LAUNCH_MEGA(pb + 1, pb + 2); }
               else { const float li = 0.8f - 0.6f * expf(-0.3f * (float)L);
                      k_t5table<<<(8191 * 8 + 255) / 256, 256, 0, stream>>>(rel_bias, tbl, lq1 + j * 64, lk1 + j * 64, lq2 + j * 64, lk2 + j * 64, lamp, li, 0.f);
                      k_diff_attn<<<M / 8, 512, 0, stream>>>(QKV, tbl, lamp, subg + j * 128, AO, 1.f - li, 0.f); } }
        if (nm & 16u) { LAUNCH_MEGA(pb + 2, pb + 3); if ((HOSTREP & 16) && L == 0) for (int r_ = 0; r_ < 4; ++r_) LAUNCH_MEGA(pb + 2, pb + 3); }
        else k_gemm<EpiResidual><<<dim3(1024 / 128, M / 128), 256, 0, stream>>>(AO, Wo_t, 1024, 1024, 1024, 0, EpiResidual{L == 0 ? x : out, out, 1024, 0});
        unsigned* cnt = ctl + CW_CNT + L * 16; unsigned* cur = ctl + CW_CUR + L * 16;
        if (nm & 32u) { LAUNCH_MEGA(pb + 3, pb + 4); if (HOSTREP & 32) { (void)hipMemsetAsync(cnt, 0, 64, stream); LAUNCH_MEGA(pb + 3, pb + 4); } }
        else k_norm_router<<<M / 4, 256, 0, stream>>>(out, ffn_g + L * 1024, rgw + (size_t)L * 1024 * 4, rgb + L * 4, rew + (size_t)L * 1024 * 16, reb + L * 16, XN, T, cnt);
        if (nm & 64u) { LAUNCH_MEGA(pb + 4, pb + 5); if (HOSTREP & 64) { (void)hipMemsetAsync(cur, 0, 64, stream); LAUNCH_MEGA(pb + 4, pb + 5); } } else k_assign<<<M / 256, 256, 0, stream>>>(cnt, cur, T, tile_e);
        if (nm & 128u) { LAUNCH_MEGA(pb + 5, pb + 6); if (HOSTREP & 128) LAUNCH_MEGA(pb + 5, pb + 6); } else k_moe_gateup<<<dim3(512 / 64, CAP / 128), 256, 0, stream>>>(XN, Wgu_t, T.slot_tok, tile_e, Hb);
        if (nm & 256u) { LAUNCH_MEGA(pb + 6, pb + 7); if (HOSTREP & 256) LAUNCH_MEGA(pb + 6, pb + 7); } else k_moe_down<<<dim3(1024 / 128, CAP / 128), 256, 0, stream>>>(Hb, Wd_t, tile_e, Yb);
        if (nm & 512u) LAUNCH_MEGA(pb + 7, pb + 8); else k_combine<<<M / 4, 256, 0, stream>>>(out, Yb, T, L + 1 < DEPTH ? mix_g + (L + 1) * 1024 : nullptr, XN);
    }
}
```
